# Optimizing an MI355X kernel written in HIP

```python
import math
import jax
import jax.numpy as jnp
from jax import lax
import numpy as np

D_MODEL = 1024
BATCH = 8
SEQ = 4096
DEPTH = 4

CHUNK = 64
Q_BLOCK = 128
NORM_EPS = 1e-6
CONV_K = 4
D_FF = 2816
N_MEM = 256

SSD_HEADS = 8
SSD_HEAD_DIM = 64
SSD_WIDTH = SSD_HEADS * SSD_HEAD_DIM
SSD_GROUPS = 2
SSD_STATE = 64
SSD_CONV_DIM = SSD_WIDTH + 2 * SSD_GROUPS * SSD_STATE
SSD_IN = SSD_WIDTH + SSD_CONV_DIM + SSD_HEADS

MLA_HEADS = 4
MLA_Q_LORA = 256
MLA_KV_LORA = 128
MLA_NOPE = 64
MLA_ROPE = 32
MLA_V = 64
MLA_WIDTH = MLA_HEADS * MLA_V
MLA_IN = MLA_Q_LORA + MLA_KV_LORA + MLA_ROPE
ROPE_THETA = 10000.0

GDN_HEADS = 4
GDN_DK = 64
GDN_DV = 64
GDN_QK_WIDTH = GDN_HEADS * GDN_DK
GDN_WIDTH = GDN_HEADS * GDN_DV
GDN_CONV_DIM = 2 * GDN_QK_WIDTH + GDN_WIDTH
GDN_IN = GDN_CONV_DIM + GDN_WIDTH + 2 * GDN_HEADS

D_MIX = SSD_WIDTH + MLA_WIDTH + GDN_WIDTH
IN_COLS = SSD_IN + MLA_IN + GDN_IN

XA_HEADS = 4
XA_HEAD_DIM = D_MODEL // XA_HEADS

N_NORMS = 9
FFN1_PRE = 0
FFN1_POST = 1
MIX_PRE = 2
MIX_POST = 3
MEM_NORM = 4
XA_PRE = 5
XA_POST = 6
FFN2_PRE = 7
FFN2_POST = 8

kernel_name = 'hybrid_ssd_mla_gdn_macaron_trunk'


def rms_norm(x, g):
    xf = x.astype(jnp.float32)
    y = xf * lax.rsqrt(jnp.mean(xf * xf, axis=-1, keepdims=True) + NORM_EPS)
    return (y * g.astype(jnp.float32)).astype(x.dtype)


def l2_normalize(x):
    return x * lax.rsqrt(jnp.sum(x * x, axis=-1, keepdims=True) + NORM_EPS)


def swiglu_ffn(x, w_up, w_down):
    gate, up = jnp.split(x @ w_up, 2, axis=-1)
    return (jax.nn.silu(gate) * up) @ w_down


def causal_depthwise_conv(x, w):
    k = w.shape[0]
    xp = jnp.pad(x, ((0, 0), (k - 1, 0), (0, 0)))
    return lax.conv_general_dilated(xp, w[:, None, :].astype(x.dtype), (1,), 'VALID',
                                    dimension_numbers=('NWC', 'WIO', 'NWC'),
                                    feature_group_count=x.shape[-1])


def rope_tables(positions):
    inv = 1.0 / (ROPE_THETA ** (jnp.arange(0, MLA_ROPE, 2, dtype=jnp.float32) / MLA_ROPE))
    ang = positions.astype(jnp.float32)[..., None] * inv
    return jnp.cos(ang), jnp.sin(ang)


def apply_rope(x, cos, sin):
    xf = x.astype(jnp.float32)
    x1, x2 = jnp.split(xf, 2, axis=-1)
    return jnp.concatenate([x1 * cos - x2 * sin, x2 * cos + x1 * sin], axis=-1).astype(x.dtype)


def ssd_mixer(cols, conv_w, conv_b, dt_bias, a_log, d_skip, norm_g):
    f32 = jnp.float32
    bsz, s_len, _ = cols.shape
    nc = s_len // CHUNK
    hpg = SSD_HEADS // SSD_GROUPS
    z, xbc, dt = jnp.split(cols, [SSD_WIDTH, SSD_WIDTH + SSD_CONV_DIM], axis=-1)
    xbc = jax.nn.silu(causal_depthwise_conv(xbc, conv_w) + conv_b)
    xs, bm, cm = jnp.split(xbc, [SSD_WIDTH, SSD_WIDTH + SSD_GROUPS * SSD_STATE], axis=-1)
    xs = xs.reshape(bsz, nc, CHUNK, SSD_GROUPS, hpg, SSD_HEAD_DIM).astype(f32)
    bm = bm.reshape(bsz, nc, CHUNK, SSD_GROUPS, SSD_STATE).astype(f32)
    cm = cm.reshape(bsz, nc, CHUNK, SSD_GROUPS, SSD_STATE).astype(f32)
    dt = jax.nn.softplus(dt.astype(f32) + dt_bias.astype(f32))
    a = -jnp.exp(a_log.astype(f32))
    dt = dt.reshape(bsz, nc, CHUNK, SSD_GROUPS, hpg)
    xdt = xs * dt[..., None]
    a_cum = jnp.cumsum(dt * a.reshape(SSD_GROUPS, hpg), axis=2)
    causal = jnp.tril(jnp.ones((CHUNK, CHUNK), bool))[:, :, None, None]
    seg = a_cum[:, :, :, None] - a_cum[:, :, None, :]
    lmat = jnp.exp(jnp.where(causal, seg, -jnp.inf))
    cb = jnp.einsum('bclgn,bcsgn->bclsg', cm, bm)
    y_diag = jnp.einsum('bclsg,bclsgh,bcsghp->bclghp', cb, lmat, xdt)
    decay_to_end = jnp.exp(a_cum[:, :, -1:] - a_cum)
    chunk_states = jnp.einsum('bclgn,bclgh,bclghp->bcghpn', bm, decay_to_end, xdt)
    chunk_decay = jnp.exp(a_cum[:, :, -1])

    def step(state, inp):
        s_c, d_c = inp
        return state * d_c[..., None, None] + s_c, state

    h0 = jnp.zeros((bsz, SSD_GROUPS, hpg, SSD_HEAD_DIM, SSD_STATE), f32)
    _, h_in = lax.scan(step, h0, (jnp.moveaxis(chunk_states, 1, 0), jnp.moveaxis(chunk_decay, 1, 0)))
    h_in = jnp.moveaxis(h_in, 0, 1)
    y_off = jnp.einsum('bclgn,bcghpn,bclgh->bclghp', cm, h_in, jnp.exp(a_cum))
    y = y_diag + y_off + xs * d_skip.astype(f32).reshape(SSD_GROUPS, hpg)[..., None]
    y = y.reshape(bsz, s_len, SSD_WIDTH) * jax.nn.silu(z.astype(f32))
    y = rms_norm(y.reshape(bsz, s_len, SSD_GROUPS, SSD_WIDTH // SSD_GROUPS),
                 norm_g.reshape(SSD_GROUPS, SSD_WIDTH // SSD_GROUPS))
    return y.reshape(bsz, s_len, SSD_WIDTH).astype(cols.dtype)


def mla_mixer(cols, cos, sin, q_norm_g, w_uq, kv_norm_g, w_ukv):
    bsz, s_len, _ = cols.shape
    c_q, c_kv, k_rope = jnp.split(cols, [MLA_Q_LORA, MLA_Q_LORA + MLA_KV_LORA], axis=-1)
    q = (rms_norm(c_q, q_norm_g) @ w_uq).reshape(bsz, s_len, MLA_HEADS, MLA_NOPE + MLA_ROPE)
    q_nope, q_rope = jnp.split(q, [MLA_NOPE], axis=-1)
    q_rope = apply_rope(q_rope, cos[:, :, None], sin[:, :, None])
    k_rope = apply_rope(k_rope, cos, sin)
    kv = (rms_norm(c_kv, kv_norm_g) @ w_ukv).reshape(bsz, s_len, MLA_HEADS, MLA_NOPE + MLA_V)
    k_nope, v = jnp.split(kv, [MLA_NOPE], axis=-1)
    scale = (MLA_NOPE + MLA_ROPE) ** -0.5
    outs = []
    for qb in range(s_len // Q_BLOCK):
        q0 = qb * Q_BLOCK
        kend = q0 + Q_BLOCK
        s = (jnp.einsum('bqhd,bkhd->bhqk', q_nope[:, q0:kend], k_nope[:, :kend])
             + jnp.einsum('bqhr,bkr->bhqk', q_rope[:, q0:kend], k_rope[:, :kend]))
        s = s.astype(jnp.float32) * scale
        q_chunk = (q0 + jnp.arange(Q_BLOCK)) // CHUNK
        k_chunk = jnp.arange(kend) // CHUNK
        s = jnp.where(k_chunk[None, :] <= q_chunk[:, None], s, -jnp.inf)
        p = jax.nn.softmax(s, axis=-1).astype(v.dtype)
        outs.append(jnp.einsum('bhqk,bkhd->bqhd', p, v[:, :kend]))
    return jnp.concatenate(outs, axis=1).reshape(bsz, s_len, MLA_WIDTH)


def gdn_mixer(cols, conv_w, dt_bias, a_log, norm_g):
    f32 = jnp.float32
    bsz, s_len, _ = cols.shape
    nc = s_len // CHUNK
    qkv, z, b_raw, a_raw = jnp.split(
        cols, [GDN_CONV_DIM, GDN_CONV_DIM + GDN_WIDTH, GDN_CONV_DIM + GDN_WIDTH + GDN_HEADS], axis=-1)
    qkv = jax.nn.silu(causal_depthwise_conv(qkv, conv_w)).astype(f32)
    q, k, v = jnp.split(qkv, [GDN_QK_WIDTH, 2 * GDN_QK_WIDTH], axis=-1)

    def to_chunks(t, d):
        return t.reshape(bsz, nc, CHUNK, GDN_HEADS, d).transpose(0, 1, 3, 2, 4)

    def heads_to_chunks(t):
        return t.reshape(bsz, nc, CHUNK, GDN_HEADS).transpose(0, 1, 3, 2)

    q = l2_normalize(to_chunks(q, GDN_DK)) * GDN_DK ** -0.5
    k = l2_normalize(to_chunks(k, GDN_DK))
    v = to_chunks(v, GDN_DV)
    beta = heads_to_chunks(jax.nn.sigmoid(b_raw.astype(f32)))
    g = -jnp.exp(a_log.astype(f32)) * jax.nn.softplus(a_raw.astype(f32) + dt_bias.astype(f32))
    g_cum = jnp.cumsum(heads_to_chunks(g), axis=-1)
    incl = jnp.tril(jnp.ones((CHUNK, CHUNK), bool))
    strict = jnp.tril(jnp.ones((CHUNK, CHUNK), bool), -1)
    gamma = jnp.exp(jnp.where(incl, g_cum[..., :, None] - g_cum[..., None, :], -jnp.inf))
    kb = k * beta[..., None]
    m = jnp.where(strict, jnp.einsum('bchld,bchsd->bchls', kb, k) * gamma, 0.0)
    eye = jnp.eye(CHUNK, dtype=f32)
    rhs = jnp.concatenate([v * beta[..., None], kb * jnp.exp(g_cum)[..., None]], axis=-1)
    sol = lax.linalg.triangular_solve(eye + m, rhs, left_side=True, lower=True, unit_diagonal=True)
    u, w = jnp.split(sol, [GDN_DV], axis=-1)
    qk = jnp.where(incl, jnp.einsum('bchld,bchsd->bchls', q, k) * gamma, 0.0)
    q_dec = q * jnp.exp(g_cum)[..., None]
    k_dec = k * jnp.exp(g_cum[..., -1:] - g_cum)[..., None]
    chunk_decay = jnp.exp(g_cum[..., -1])

    def step(state, inp):
        u_c, w_c, qk_c, qd_c, kd_c, dec_c = inp
        v_new = u_c - jnp.einsum('bhld,bhdv->bhlv', w_c, state)
        o_c = jnp.einsum('bhld,bhdv->bhlv', qd_c, state) + jnp.einsum('bhls,bhsv->bhlv', qk_c, v_new)
        state = state * dec_c[..., None, None] + jnp.einsum('bhld,bhlv->bhdv', kd_c, v_new)
        return state, o_c

    s0 = jnp.zeros((bsz, GDN_HEADS, GDN_DK, GDN_DV), f32)
    xs = (jnp.moveaxis(u, 1, 0), jnp.moveaxis(w, 1, 0), jnp.moveaxis(qk, 1, 0),
          jnp.moveaxis(q_dec, 1, 0), jnp.moveaxis(k_dec, 1, 0), jnp.moveaxis(chunk_decay, 1, 0))
    _, o = lax.scan(step, s0, xs)
    o = jnp.moveaxis(o, 0, 1).transpose(0, 1, 3, 2, 4).reshape(bsz, s_len, GDN_HEADS, GDN_DV)
    o = rms_norm(o, norm_g) * jax.nn.silu(z.astype(f32).reshape(bsz, s_len, GDN_HEADS, GDN_DV))
    return o.reshape(bsz, s_len, GDN_WIDTH).astype(cols.dtype)


def memory_cross_attention(u, mem_n, w_q, w_kv, w_o):
    bsz, s_len, _ = u.shape
    n_mem = mem_n.shape[1]
    q = (u @ w_q).reshape(bsz, s_len, XA_HEADS, XA_HEAD_DIM)
    k, v = jnp.split(mem_n @ w_kv, 2, axis=-1)
    k = k.reshape(bsz, n_mem, XA_HEADS, XA_HEAD_DIM)
    v = v.reshape(bsz, n_mem, XA_HEADS, XA_HEAD_DIM)
    s = jnp.einsum('bqhd,bmhd->bhqm', q, k).astype(jnp.float32) * XA_HEAD_DIM ** -0.5
    p = jax.nn.softmax(s, axis=-1).astype(v.dtype)
    o = jnp.einsum('bhqm,bmhd->bqhd', p, v).reshape(bsz, s_len, D_MODEL)
    return o @ w_o


def _dt_bias(k, shape):
    dt = jnp.exp(jax.random.uniform(k, shape, jnp.float32, math.log(1e-3), math.log(1e-1)))
    return dt + jnp.log(-jnp.expm1(-dt))


def setup_inputs(seed: int = 0) -> dict:
    key = jax.random.key(seed)
    ks = jax.random.split(key, 25)
    f32 = jnp.float32

    def dense(k, shape, fan_in):
        return jax.random.normal(k, shape, f32) * fan_in ** -0.5

    def gain(k, shape):
        return 1.0 + 0.02 * jax.random.normal(k, shape, f32)

    x = jax.random.normal(ks[0], (BATCH, SEQ, D_MODEL), f32)
    mem = jax.random.normal(ks[1], (BATCH, N_MEM, D_MODEL), f32)
    offsets = jax.random.randint(ks[2], (BATCH, 1), 0, 4096, dtype=jnp.int32)
    positions = offsets + jnp.arange(SEQ, dtype=jnp.int32)[None, :]
    return {
        'x': x,
        'mem': mem,
        'positions': positions,
        'norm_g': gain(ks[3], (DEPTH, N_NORMS, D_MODEL)),
        'ffn_w_up': dense(ks[4], (DEPTH, 2, D_MODEL, 2 * D_FF), D_MODEL),
        'ffn_w_down': dense(ks[5], (DEPTH, 2, D_FF, D_MODEL), D_FF),
        'w_in': dense(ks[6], (DEPTH, D_MODEL, IN_COLS), D_MODEL),
        'ssd_conv_w': dense(ks[7], (DEPTH, CONV_K, SSD_CONV_DIM), CONV_K),
        'ssd_conv_b': 0.02 * jax.random.normal(ks[8], (DEPTH, SSD_CONV_DIM), f32),
        'ssd_dt_bias': _dt_bias(ks[9], (DEPTH, SSD_HEADS)),
        'ssd_a_log': jnp.log(jax.random.uniform(ks[10], (DEPTH, SSD_HEADS), f32, 1.0, 16.0)),
        'ssd_d': 1.0 + 0.1 * jax.random.normal(ks[11], (DEPTH, SSD_HEADS), f32),
        'ssd_norm_g': gain(ks[12], (DEPTH, SSD_WIDTH)),
        'mla_q_norm_g': gain(ks[13], (DEPTH, MLA_Q_LORA)),
        'mla_w_uq': dense(ks[14], (DEPTH, MLA_Q_LORA, MLA_HEADS * (MLA_NOPE + MLA_ROPE)), MLA_Q_LORA),
        'mla_kv_norm_g': gain(ks[15], (DEPTH, MLA_KV_LORA)),
        'mla_w_ukv': dense(ks[16], (DEPTH, MLA_KV_LORA, MLA_HEADS * (MLA_NOPE + MLA_V)), MLA_KV_LORA),
        'gdn_conv_w': dense(ks[17], (DEPTH, CONV_K, GDN_CONV_DIM), CONV_K),
        'gdn_dt_bias': _dt_bias(ks[18], (DEPTH, GDN_HEADS)),
        'gdn_a_log': jnp.log(jax.random.uniform(ks[19], (DEPTH, GDN_HEADS), f32, 1.0, 16.0)),
        'gdn_norm_g': gain(ks[20], (DEPTH, GDN_DV)),
        'w_out': dense(ks[21], (DEPTH, D_MIX, D_MODEL), D_MIX),
        'xa_w_q': dense(ks[22], (DEPTH, D_MODEL, D_MODEL), D_MODEL),
        'xa_w_kv': dense(ks[23], (DEPTH, D_MODEL, 2 * D_MODEL), D_MODEL),
        'xa_w_o': dense(ks[24], (DEPTH, D_MODEL, D_MODEL), D_MODEL),
    }


def reference(x, mem, positions, norm_g, ffn_w_up, ffn_w_down, w_in, ssd_conv_w, ssd_conv_b,
              ssd_dt_bias, ssd_a_log, ssd_d, ssd_norm_g, mla_q_norm_g, mla_w_uq, mla_kv_norm_g,
              mla_w_ukv, gdn_conv_w, gdn_dt_bias, gdn_a_log, gdn_norm_g, w_out, xa_w_q, xa_w_kv,
              xa_w_o):
    cos, sin = rope_tables(positions)
    h = x
    for i in range(DEPTH):
        g = norm_g[i]
        ff = swiglu_ffn(rms_norm(h, g[FFN1_PRE]), ffn_w_up[i, 0], ffn_w_down[i, 0])
        h = h + 0.5 * rms_norm(ff, g[FFN1_POST])
        u = rms_norm(h, g[MIX_PRE])
        cols = u @ w_in[i]
        c_ssd, c_mla, c_gdn = jnp.split(cols, [SSD_IN, SSD_IN + MLA_IN], axis=-1)
        y_ssd = ssd_mixer(c_ssd, ssd_conv_w[i], ssd_conv_b[i], ssd_dt_bias[i], ssd_a_log[i],
                          ssd_d[i], ssd_norm_g[i])
        y_mla = mla_mixer(c_mla, cos, sin, mla_q_norm_g[i], mla_w_uq[i], mla_kv_norm_g[i], mla_w_ukv[i])
        y_gdn = gdn_mixer(c_gdn, gdn_conv_w[i], gdn_dt_bias[i], gdn_a_log[i], gdn_norm_g[i])
        y = jnp.concatenate([y_ssd, y_mla, y_gdn], axis=-1)
        h = h + rms_norm(y @ w_out[i], g[MIX_POST])
        xa = memory_cross_attention(rms_norm(h, g[XA_PRE]), rms_norm(mem, g[MEM_NORM]),
                                    xa_w_q[i], xa_w_kv[i], xa_w_o[i])
        h = h + rms_norm(xa, g[XA_POST])
        ff = swiglu_ffn(rms_norm(h, g[FFN2_PRE]), ffn_w_up[i, 1], ffn_w_down[i, 1])
        h = h + 0.5 * rms_norm(ff, g[FFN2_POST])
    return h
```

```cpp
#include <hip/hip_runtime.h>
#include <hip/hip_cooperative_groups.h>
#include <cstdio>
#include <cstdint>
namespace cg = cooperative_groups;

#define LAS __attribute__((address_space(3)))
typedef unsigned short bf16_t;
typedef short bf16x8 __attribute__((ext_vector_type(8)));
typedef float f32x4 __attribute__((ext_vector_type(4)));
typedef unsigned u32x4 __attribute__((ext_vector_type(4)));
typedef unsigned u32x2 __attribute__((ext_vector_type(2)));

constexpr int NB = 8, SEQ = 4096, T = NB * SEQ, D = 1024, FF = 2816, DEPTH = 4, NMEM = 256;
constexpr int LDC = 2816;
constexpr int SSD_Z = 0, SSD_XBC = 512, SSD_DT = 1280;
constexpr int MLA_CQ = 1288, MLA_CKV = 1544, MLA_KR = 1672;
constexpr int GDN_QKV = 1704, GDN_Z = 2472, GDN_B = 2728, GDN_A = 2732;
constexpr float EPS = 1e-6f;
constexpr int NT = 512;
constexpr int LDS_BYTES = 143360;
constexpr int MISC_OFF = 142848;

constexpr size_t W_UP0 = 0, W_UP1 = 5767168, W_DN0 = 11534336, W_DN1 = 14417920, W_IN = 17301504, W_OUT = 20185088,
                 W_XQ = 21233664, W_XKV = 22282240, W_XO = 24379392, W_UQ = 25427968, W_UKV = 25559040, WL_ELEMS = 25624576;

constexpr size_t WS_CTL = 0;
constexpr size_t WS_COS = 4096;
constexpr size_t WS_SIN = WS_COS + (size_t)T * 16 * 4;
constexpr size_t WS_SSQQ = WS_SIN + (size_t)T * 16 * 4;
constexpr size_t WS_SSQKV = WS_SSQQ + (size_t)T * 4;
constexpr size_t WS_SSDP = WS_SSQKV + (size_t)T * 4;
constexpr size_t WS_GDEC = WS_SSDP + (size_t)T * 16 * 4;
constexpr size_t WS_MEMN = WS_GDEC + 8192;
constexpr size_t WS_XK = WS_MEMN + (size_t)4 * 2048 * 1024 * 2;
constexpr size_t WS_XVT = WS_XK + (size_t)4 * 2048 * 1024 * 2;
constexpr size_t WS_W = WS_XVT + (size_t)4 * 2048 * 1024 * 2;
constexpr size_t WS_TBUF = WS_W + (size_t)DEPTH * WL_ELEMS * 2;
constexpr size_t WS_HB = WS_TBUF + (size_t)T * 1024 * 4;
constexpr size_t WS_BIG = WS_HB + (size_t)T * 1024 * 2;
constexpr size_t WS_Y = WS_BIG + (size_t)T * 2816 * 2;
constexpr size_t WS_CMS = WS_Y + (size_t)T * 1024 * 2;
constexpr size_t WS_SAC = WS_CMS + (size_t)1024 * 4096 * 2;
constexpr size_t WS_XBAR = WS_SAC + (size_t)4096 * 64 * 4;
constexpr size_t WS_END = WS_XBAR + 16384;
constexpr size_t WS_MQ = WS_TBUF;
constexpr size_t WS_MK = WS_MQ + (size_t)T * 512 * 2;
constexpr size_t WS_MVT = WS_MK + (size_t)T * 384 * 2;
constexpr size_t WS_GP = WS_MVT + (size_t)8 * 256 * 4096 * 2;
constexpr size_t WS_SST = WS_GP + (size_t)2048 * 5 * 4096 * 2;
constexpr size_t WS_MIXEND = WS_SST + (size_t)4096 * 4096 * 2;
static_assert(WS_MIXEND <= WS_BIG, "mixer scratch must fit in TBUF+HB");

typedef float f32x2_t __attribute__((ext_vector_type(2)));
typedef __bf16 bf16x2_t __attribute__((ext_vector_type(2)));
__device__ __forceinline__ unsigned pk2(float lo, float hi) { const f32x2_t v = {lo, hi}; const bf16x2_t b = __builtin_convertvector(v, bf16x2_t); return __builtin_bit_cast(unsigned, b); }
__device__ __forceinline__ unsigned f2bf(float f) { return pk2(f, f) & 0xffffu; }
__device__ __forceinline__ float bf2f(unsigned b) { return __builtin_bit_cast(float, (b & 0xffffu) << 16); }
__device__ __forceinline__ float bflo(unsigned w) { return __builtin_bit_cast(float, w << 16); }
__device__ __forceinline__ float bfhi(unsigned w) { return __builtin_bit_cast(float, w & 0xffff0000u); }
__device__ __forceinline__ float silu_f(float x) { return x * __builtin_amdgcn_rcpf(1.f + __expf(-x)); }
__device__ __forceinline__ float softplus_f(float x) { return x > 20.f ? x : __logf(1.f + __expf(x)); }
__device__ __forceinline__ unsigned hw_slot() { return (unsigned)__builtin_amdgcn_s_getreg((5 << 11) | 4) & 63u; }
__device__ __forceinline__ int tid_o() {
    const int wv = __builtin_amdgcn_readfirstlane(*(volatile LAS int*)(unsigned)(MISC_OFF + 64 + hw_slot() * 4));
    int ln; asm volatile("v_mbcnt_lo_u32_b32 %0, -1, 0\n\tv_mbcnt_hi_u32_b32 %0, -1, %0" : "=v"(ln));
    return wv * 64 + ln; }
__device__ __forceinline__ int bid_o() { int b = blockIdx.x; asm volatile("" : "+s"(b)); return b; }
#define MFMA16(a, b, c) __builtin_amdgcn_mfma_f32_16x16x32_bf16(a, b, c, 0, 0, 0)

namespace pg8 {
constexpr int BM = 256, BK = 64, HALF = 128, HTB = HALF * BK * 2, STAGE_BYTES = 8 * HTB, NXCD = 8, WGM = 8;
__device__ __forceinline__ int lds_byte(int r, int c) { const int st = (r >> 4) * 2 + (c >> 5), rr = r & 15, cc = c & 31, ob = rr * 64 + cc * 2; return st * 1024 + (ob ^ (((ob >> 9) & 1) << 5)); }
__device__ __forceinline__ void stage_rc(int b, int& R, int& C) { const int st = b / 1024, sb = b % 1024, swz = sb ^ (((sb >> 9) & 1) << 5); R = (st >> 1) * 16 + swz / 64; C = (st & 1) * 32 + (swz % 64) / 2; }
__device__ __forceinline__ int perm32(int rho) { const int n = rho >> 4, i = rho & 15; return 8 * (i >> 2) + 4 * n + (i & 3); }
struct Unit { int pm, pn; };
struct Gemm { const bf16_t* A; const bf16_t* Bt; int lda, ldb, M, N, K; };
struct StaticOrder {
    int nM, nN, nwg, G, c;
    __device__ void init(int M, int N, int G_, int c_) { nM = M / BM; nN = N / BM; nwg = nM * nN; G = G_; c = c_; }
    __device__ bool next(int i, Unit& u) const {
        const long L = (long)i * G + c; if (L >= nwg) return false;
        int wgid = (int)L; { const int q = nwg / NXCD, r = nwg % NXCD, xcd = wgid % NXCD, off = wgid / NXCD; wgid = (xcd < r ? xcd * (q + 1) : r * (q + 1) + (xcd - r) * q) + off; }
        const int nig = WGM * nN, gid = wgid / nig, fm = gid * WGM, gsz = (nM - fm) < WGM ? (nM - fm) : WGM;
        u.pm = fm + ((wgid % nig) % gsz); u.pn = (wgid % nig) / gsz; return true;
    }
};
template <class Epi>
__device__ __forceinline__ void gemm_phase(LAS unsigned char* lds, const Gemm g, const StaticOrder& S, const Epi& E) {
    const int tid = tid_o(), wid = __builtin_amdgcn_readfirstlane(tid >> 6), lane = tid & 63, wr = wid >> 2, wc = wid & 3, fr = lane & 15, fq = lane >> 4;
    const int K = g.K, nt = K / BK;
    unsigned voffA[2], voffB[2];
#pragma unroll
    for (int i = 0; i < 2; ++i) { int R, C; stage_rc(tid * 16 + i * 8192, R, C); const int Rb = (R & ~31) + perm32(R & 31);
        voffA[i] = (unsigned)(R * g.lda + C) * 2u; voffB[i] = (unsigned)(Rb * g.ldb + C) * 2u; }
    const size_t kstep = (size_t)(BK * 2);
    const size_t hA = (size_t)HALF * g.lda * 2, hB = (size_t)HALF * g.ldb * 2;
    const size_t tA = 2 * hA, tB = 2 * hB;
    const unsigned ldsw = (unsigned)wid * 1024u;
    const int aoff = lds_byte(wr * 64 + fr, fq * 8), boff = lds_byte(wc * 32 + fr, fq * 8);
#define PG8_SA(b, h) (((b) * 2 + (h)) * HTB)
#define PG8_SB(b, h) ((4 + (b) * 2 + (h)) * HTB)
#define PG8_STAGE(bufoff, gbase, voff) do { _Pragma("unroll") for (int _i = 0; _i < 2; ++_i) \
        __builtin_amdgcn_global_load_lds((const unsigned*)((const char*)(gbase) + (voff)[_i]), (LAS unsigned*)(lds + (bufoff) + ldsw + _i * 8192), 16, 0, 0); } while (0)
#define PG8_LDA(dst, b, h) do { _Pragma("unroll") for (int m = 0; m < 4; ++m) _Pragma("unroll") for (int k = 0; k < 2; ++k) dst[m][k] = *(const LAS bf16x8*)(lds + PG8_SA(b, h) + aoff + m * 2048 + k * 1024); } while (0)
#define PG8_LDB(dst, b, h) do { _Pragma("unroll") for (int n = 0; n < 2; ++n) _Pragma("unroll") for (int k = 0; k < 2; ++k) dst[n][k] = *(const LAS bf16x8*)(lds + PG8_SB(b, h) + boff + n * 2048 + k * 1024); } while (0)
#define PG8_MMA(ai, bj, At, Bt) do { __builtin_amdgcn_s_setprio(1); _Pragma("unroll") for (int m = 0; m < 4; ++m) _Pragma("unroll") for (int n = 0; n < 2; ++n) _Pragma("unroll") for (int k = 0; k < 2; ++k) \
        acc[ai][bj][m][n] = __builtin_amdgcn_mfma_f32_16x16x32_bf16(Bt[n][k], At[m][k], acc[ai][bj][m][n], 0, 0, 0); __builtin_amdgcn_s_setprio(0); } while (0)
#define PG8_WAIT_V(n) asm volatile("s_waitcnt vmcnt(" #n ")" ::: "memory")
#define PG8_WAIT_L(n) asm volatile("s_waitcnt lgkmcnt(" #n ")" ::: "memory")
#define PG8_BAR __builtin_amdgcn_s_barrier()
#define PG8_SCHED __builtin_amdgcn_sched_barrier(0)
    Unit cur, nxt; int ui = 0;
    if (!S.next(0, cur)) return;
    f32x4 acc[2][2][4][2];
#pragma unroll
    for (int a = 0; a < 2; ++a)
#pragma unroll
        for (int b = 0; b < 2; ++b)
#pragma unroll
            for (int m = 0; m < 4; ++m)
#pragma unroll
                for (int n = 0; n < 2; ++n) acc[a][b][m][n] = (f32x4){0.f, 0.f, 0.f, 0.f};
    bf16x8 At[4][2], B0[2][2], B1[2][2];
    const char* cA = (const char*)g.A + (size_t)cur.pm * tA; const char* cB = (const char*)g.Bt + (size_t)cur.pn * tB;
    PG8_STAGE(PG8_SB(0, 0), cB, voffB); PG8_STAGE(PG8_SB(0, 1), cB + hB, voffB); PG8_STAGE(PG8_SA(0, 0), cA, voffA); PG8_STAGE(PG8_SA(0, 1), cA + hA, voffA);
    if (wr == 1) PG8_BAR;
    PG8_WAIT_V(2); PG8_BAR;
    PG8_STAGE(PG8_SB(1, 0), cB + kstep, voffB); PG8_STAGE(PG8_SA(1, 0), cA + kstep, voffA); PG8_STAGE(PG8_SB(1, 1), cB + hB + kstep, voffB);
    PG8_WAIT_V(6); PG8_BAR;
    for (;;) {
        const bool has_next = S.next(ui + 1, nxt);
        const char* nA = has_next ? (const char*)g.A + (size_t)nxt.pm * tA : cA; const char* nB = has_next ? (const char*)g.Bt + (size_t)nxt.pn * tB : cB;
        for (int t = 0; t < nt; t += 2) {
            const bool last = (t == nt - 2);
            const char* a1 = cA + (size_t)(t + 1) * kstep;
            const char* a2 = last ? nA : cA + (size_t)(t + 2) * kstep; const char* b2 = last ? nB : cB + (size_t)(t + 2) * kstep;
            const char* a3 = a2 + kstep; const char* b3 = b2 + kstep;
            PG8_LDB(B0, 0, 0); PG8_LDB(B1, 0, 1); PG8_SCHED; PG8_LDA(At, 0, 0); PG8_STAGE(PG8_SA(1, 1), a1 + hA, voffA);
            PG8_WAIT_V(8); PG8_WAIT_L(0); PG8_BAR; PG8_MMA(0, 0, At, B0); PG8_MMA(0, 1, At, B1); PG8_BAR; PG8_SCHED;
            PG8_LDA(At, 0, 1); PG8_STAGE(PG8_SB(0, 0), b2, voffB); PG8_STAGE(PG8_SB(0, 1), b2 + hB, voffB); PG8_STAGE(PG8_SA(0, 0), a2, voffA);
            PG8_WAIT_V(8); PG8_WAIT_L(0); PG8_BAR; PG8_MMA(1, 0, At, B0); PG8_MMA(1, 1, At, B1); PG8_BAR; PG8_SCHED;
            PG8_LDB(B0, 1, 0); PG8_LDB(B1, 1, 1); PG8_SCHED; PG8_LDA(At, 1, 0); PG8_STAGE(PG8_SA(0, 1), a2 + hA, voffA);
            PG8_WAIT_V(8); PG8_WAIT_L(0); PG8_BAR; PG8_MMA(0, 0, At, B0); PG8_MMA(0, 1, At, B1); PG8_BAR; PG8_SCHED;
            PG8_LDA(At, 1, 1); PG8_STAGE(PG8_SB(1, 0), b3, voffB); PG8_STAGE(PG8_SB(1, 1), b3 + hB, voffB); PG8_STAGE(PG8_SA(1, 0), a3, voffA);
            PG8_WAIT_V(8); PG8_WAIT_L(0); PG8_BAR; PG8_MMA(1, 0, At, B0); PG8_MMA(1, 1, At, B1); PG8_BAR; PG8_SCHED;
        }
        if (wr == 0) PG8_BAR;
        { int fr_e = fr, fq_e = fq; asm volatile("" : "+v"(fr_e), "+v"(fq_e)); E(acc, cur, wr, wc, fr_e, fq_e); }
        if (!has_next) break;
#pragma unroll
        for (int a = 0; a < 2; ++a)
#pragma unroll
            for (int b = 0; b < 2; ++b)
#pragma unroll
                for (int m = 0; m < 4; ++m)
#pragma unroll
                    for (int n = 0; n < 2; ++n) acc[a][b][m][n] = (f32x4){0.f, 0.f, 0.f, 0.f};
        cur = nxt; cA = nA; cB = nB; ++ui;
        if (wr == 1) PG8_BAR;
    }
    PG8_WAIT_V(0);
    PG8_BAR;
#undef PG8_SA
#undef PG8_SB
#undef PG8_STAGE
#undef PG8_LDA
#undef PG8_LDB
#undef PG8_MMA
#undef PG8_WAIT_V
#undef PG8_WAIT_L
#undef PG8_BAR
#undef PG8_SCHED
}
typedef const f32x4 (&AccRef)[2][2][4][2];
__device__ __forceinline__ u32x4 pack8(f32x4 a, f32x4 b) { u32x4 w; w.x = pk2(a[0], a[1]); w.y = pk2(a[2], a[3]); w.z = pk2(b[0], b[1]); w.w = pk2(b[2], b[3]); return w; }

struct EpiSwiGLU { bf16_t* O;
    __device__ __forceinline__ void operator()(AccRef acc, const Unit& u, int wr, int wc, int fr, int fq) const {
        const int row0 = u.pm * BM + wr * 64 + fr, col0 = u.pn * 128 + wc * 32 + fq * 8;
#pragma unroll
        for (int ai = 0; ai < 2; ++ai)
#pragma unroll
            for (int m = 0; m < 4; ++m) { const int row = row0 + ai * HALF + m * 16; f32x4 v0, v1;
#pragma unroll
                for (int j = 0; j < 4; ++j) { v0[j] = silu_f(acc[ai][0][m][0][j]) * acc[ai][1][m][0][j]; v1[j] = silu_f(acc[ai][0][m][1][j]) * acc[ai][1][m][1][j]; }
                __builtin_nontemporal_store(pack8(v0, v1), (u32x4*)(O + (size_t)row * FF + col0)); }
    }
};
struct EpiF32 { float* O; int ldc;
    __device__ __forceinline__ void operator()(AccRef acc, const Unit& u, int wr, int wc, int fr, int fq) const {
        const int row0 = u.pm * BM + wr * 64 + fr, col0 = u.pn * BM + wc * 32 + fq * 8;
#pragma unroll
        for (int ai = 0; ai < 2; ++ai)
#pragma unroll
            for (int m = 0; m < 4; ++m) { float* rp = O + (size_t)(row0 + ai * HALF + m * 16) * ldc + col0;
#pragma unroll
                for (int bj = 0; bj < 2; ++bj) { *(f32x4*)(rp + bj * HALF) = acc[ai][bj][m][0]; *(f32x4*)(rp + bj * HALF + 4) = acc[ai][bj][m][1]; } }
    }
};
struct EpiBf16S { bf16_t* O; int ldc; float sc;
    __device__ __forceinline__ void operator()(AccRef acc, const Unit& u, int wr, int wc, int fr, int fq) const {
        const int row0 = u.pm * BM + wr * 64 + fr, col0 = u.pn * BM + wc * 32 + fq * 8;
#pragma unroll
        for (int ai = 0; ai < 2; ++ai)
#pragma unroll
            for (int m = 0; m < 4; ++m) { bf16_t* rp = O + (size_t)(row0 + ai * HALF + m * 16) * ldc + col0;
#pragma unroll
                for (int bj = 0; bj < 2; ++bj) __builtin_nontemporal_store(pack8(acc[ai][bj][m][0] * sc, acc[ai][bj][m][1] * sc), (u32x4*)(rp + bj * HALF)); }
    }
};
struct EpiCols { bf16_t* O; float* ssqq; float* ssqkv;
    __device__ __forceinline__ void operator()(AccRef acc, const Unit& u, int wr, int wc, int fr, int fq) const {
        const int row0 = u.pm * BM + wr * 64 + fr, col0 = u.pn * BM + wc * 32 + fq * 8;
#pragma unroll
        for (int ai = 0; ai < 2; ++ai)
#pragma unroll
            for (int m = 0; m < 4; ++m) { const int row = row0 + ai * HALF + m * 16; bf16_t* rp = O + (size_t)row * LDC + col0;
#pragma unroll
                for (int bj = 0; bj < 2; ++bj) { const f32x4 v0 = acc[ai][bj][m][0], v1 = acc[ai][bj][m][1];
                    *(u32x4*)(rp + bj * HALF) = pack8(v0, v1);
                    const int c = col0 + bj * HALF;
                    if (c >= MLA_CQ && c < MLA_KR) { float s = 0.f;
#pragma unroll
                        for (int j = 0; j < 4; ++j) s += v0[j] * v0[j] + v1[j] * v1[j];
                        __hip_atomic_fetch_add((c < MLA_CKV ? ssqq : ssqkv) + row, s, __ATOMIC_RELAXED, __HIP_MEMORY_SCOPE_AGENT); } } }
    }
};
struct EpiMlaQ { bf16_t* O; const LAS float* rsl;
    __device__ __forceinline__ void operator()(AccRef acc, const Unit& u, int wr, int wc, int fr, int fq) const {
        const int row0 = u.pm * BM + wr * 64 + fr, col0 = u.pn * BM + wc * 32 + fq * 8;
#pragma unroll
        for (int ai = 0; ai < 2; ++ai)
#pragma unroll
            for (int m = 0; m < 4; ++m) { const int row = row0 + ai * HALF + m * 16; const float rs = rsl[wr * 64 + fr + ai * HALF + m * 16]; bf16_t* rp = O + (size_t)row * 512 + col0;
#pragma unroll
                for (int bj = 0; bj < 2; ++bj) *(u32x4*)(rp + bj * HALF) = pack8(acc[ai][bj][m][0] * rs, acc[ai][bj][m][1] * rs); }
    }
};
struct EpiMlaKV { bf16_t* Kb; bf16_t* VT; const LAS float* rsl;
    __device__ __forceinline__ void operator()(AccRef acc, const Unit& u, int wr, int wc, int fr, int fq) const {
        const int row0 = u.pm * BM + wr * 64 + fr;
#pragma unroll
        for (int ai = 0; ai < 2; ++ai)
#pragma unroll
            for (int m = 0; m < 4; ++m) { const int row = row0 + ai * HALF + m * 16; const float rs = rsl[wr * 64 + fr + ai * HALF + m * 16];
                const int b = row >> 12, s = row & 4095;
#pragma unroll
                for (int bj = 0; bj < 2; ++bj) { const int cb = u.pn * BM + bj * HALF + wc * 32; const int h = cb >> 7, e0 = cb & 127;
                    const f32x4 v0 = acc[ai][bj][m][0] * rs, v1 = acc[ai][bj][m][1] * rs;
                    if (e0 < 64) *(u32x4*)(Kb + (size_t)row * 384 + h * 96 + e0 + fq * 8) = pack8(v0, v1);
                    else { bf16_t* vp = VT + ((size_t)(b * 256 + h * 64 + e0 - 64 + fq * 8) * 4096) + s;
#pragma unroll
                        for (int j = 0; j < 4; ++j) { vp[(size_t)j * 4096] = (bf16_t)f2bf(v0[j]); vp[(size_t)(4 + j) * 4096] = (bf16_t)f2bf(v1[j]); } } } }
    }
};
struct EpiXaKV { bf16_t* Kb; bf16_t* VT;
    __device__ __forceinline__ void operator()(AccRef acc, const Unit& u, int wr, int wc, int fr, int fq) const {
        const int row0 = u.pm * BM + wr * 64 + fr, col0 = u.pn * BM + wc * 32 + fq * 8;
#pragma unroll
        for (int ai = 0; ai < 2; ++ai)
#pragma unroll
            for (int m = 0; m < 4; ++m) { const int row = row0 + ai * HALF + m * 16;
#pragma unroll
                for (int bj = 0; bj < 2; ++bj) { const int c = col0 + bj * HALF; const f32x4 v0 = acc[ai][bj][m][0], v1 = acc[ai][bj][m][1];
                    if (c < 1024) *(u32x4*)(Kb + (size_t)row * 1024 + c) = pack8(v0, v1);
                    else { bf16_t* vp = VT + (size_t)(c - 1024) * 2048 + row;
#pragma unroll
                        for (int j = 0; j < 4; ++j) { vp[(size_t)j * 2048] = (bf16_t)f2bf(v0[j]); vp[(size_t)(4 + j) * 2048] = (bf16_t)f2bf(v1[j]); } } } }
    }
};
}

__device__ __forceinline__ void lds_barrier() { asm volatile("s_waitcnt lgkmcnt(0)" ::: "memory"); __builtin_amdgcn_s_barrier(); asm volatile("" ::: "memory"); }
template <int CTRL> __device__ __forceinline__ float dppf(float v) { return __builtin_bit_cast(float, __builtin_amdgcn_update_dpp(0, __builtin_bit_cast(int, v), CTRL, 0xF, 0xF, true)); }
__device__ __forceinline__ float row16_max(float v) { v = fmaxf(v, dppf<0xB1>(v)); v = fmaxf(v, dppf<0x4E>(v)); v = fmaxf(v, dppf<0x141>(v)); v = fmaxf(v, dppf<0x140>(v)); return v; }
__device__ __forceinline__ float row16_sum(float v) { v += dppf<0xB1>(v); v += dppf<0x4E>(v); v += dppf<0x141>(v); v += dppf<0x140>(v); return v; }
__device__ __forceinline__ float bperm_f(float v, int srclane) { return __builtin_bit_cast(float, __builtin_amdgcn_ds_bpermute(srclane << 2, __builtin_bit_cast(int, v))); }
__device__ __forceinline__ float wave_sum(float v, int lane) { v = row16_sum(v); v += bperm_f(v, lane ^ 16); v += bperm_f(v, lane ^ 32); return v; }
__device__ __forceinline__ float row8_sum(float v) { v += dppf<0xB1>(v); v += dppf<0x4E>(v); v += dppf<0x141>(v); return v; }
__device__ __forceinline__ bf16x8 lds_frag(const LAS unsigned char* p) { return *(const LAS bf16x8*)p; }

template <int DQK, int DV, int NST>
__device__ __forceinline__ void attn_item(LAS unsigned char* lds, const bf16_t* Q, int ldq, const bf16_t* Kp, int ldk, const bf16_t* VT, int ldv,
                                          bf16_t* Y, int ldy, int nkt, int nkt_lo, const float* cs, const float* sn) {
    constexpr int KS = DQK / 32, KST = DQK + 8, NVT = DV / 16;
    constexpr int KT_BYTES = 64 * KST * 2, VT_BYTES = DV * 72 * 2, ST_BYTES = KT_BYTES + VT_BYTES;
    constexpr int KPC = 64 * DQK / 8, VPC = DV * 8;
    constexpr int KPT = (KPC + NT - 1) / NT, VPT = (VPC + NT - 1) / NT;
    static_assert(NST * ST_BYTES <= MISC_OFF, "attention LDS");
    const int tid = tid_o(), wid = tid >> 6, lane = tid & 63, r = lane & 15, q = lane >> 4;
    bf16x8 qf[KS];
#pragma unroll
    for (int ks = 0; ks < KS; ++ks) qf[ks] = *(const bf16x8*)(Q + (size_t)(wid * 16 + r) * ldq + ks * 32 + q * 8);
    if constexpr (DQK == 96) {
        const f32x4 c4 = *(const f32x4*)(cs + (size_t)(wid * 16 + r) * 16 + q * 4), s4 = *(const f32x4*)(sn + (size_t)(wid * 16 + r) * 16 + q * 4);
        const u32x4 w = __builtin_bit_cast(u32x4, qf[2]);
        const f32x4 x1 = {bflo(w.x), bfhi(w.x), bflo(w.y), bfhi(w.y)}, x2 = {bflo(w.z), bfhi(w.z), bflo(w.w), bfhi(w.w)};
        qf[2] = __builtin_bit_cast(bf16x8, pg8::pack8(x1 * c4 - x2 * s4, x2 * c4 + x1 * s4)); }
    f32x4 o[NVT];
#pragma unroll
    for (int i = 0; i < NVT; ++i) o[i] = (f32x4){0.f, 0.f, 0.f, 0.f};
    float mrow = -1e30f, lrow = 0.f;
    const int my_nkt = (wid < 4) ? nkt_lo : nkt;
    u32x4 kreg[KPT], vreg[VPT];
#define ATT_LOAD(KT_) do { const bf16_t* Kn = Kp + (size_t)(KT_) * 64 * ldk; const bf16_t* Vn = VT + (size_t)(KT_) * 64; \
        _Pragma("unroll") for (int i = 0; i < KPT; ++i) { const int p = tid + i * NT; if (p < KPC) { const int row = p / (DQK / 8), pc = p % (DQK / 8); kreg[i] = *(const u32x4*)(Kn + (size_t)row * ldk + pc * 8); } } \
        _Pragma("unroll") for (int i = 0; i < VPT; ++i) { const int p = tid + i * NT; if (p < VPC) { const int row = p >> 3, pc = p & 7; vreg[i] = *(const u32x4*)(Vn + (size_t)row * ldv + pc * 8); } } } while (0)
#define ATT_STORE(STG_) do { LAS unsigned char* kd = lds + (STG_) * ST_BYTES; LAS unsigned char* vd = kd + KT_BYTES; \
        _Pragma("unroll") for (int i = 0; i < KPT; ++i) { const int p = tid + i * NT; if (p < KPC) { const int row = p / (DQK / 8), pc = p % (DQK / 8); *(LAS u32x4*)(kd + (row * KST + pc * 8) * 2) = kreg[i]; } } \
        _Pragma("unroll") for (int i = 0; i < VPT; ++i) { const int p = tid + i * NT; if (p < VPC) { const int row = p >> 3, pc = p & 7; *(LAS u32x4*)(vd + (row * 72 + pc * 8) * 2) = vreg[i]; } } } while (0)
    __syncthreads();
    ATT_LOAD(0); ATT_STORE(0);
    __syncthreads();
    for (int kt = 0; kt < nkt; ++kt) {
        const int stg = (NST == 2) ? (kt & 1) : 0;
        LAS unsigned char* kt_l = lds + stg * ST_BYTES; LAS unsigned char* vt_l = kt_l + KT_BYTES;
        if (kt + 1 < nkt) ATT_LOAD(kt + 1);
        if (kt < my_nkt) {
            f32x4 st[4];
#pragma unroll
            for (int nt = 0; nt < 4; ++nt) { st[nt] = (f32x4){0.f, 0.f, 0.f, 0.f};
#pragma unroll
                for (int ks = 0; ks < KS; ++ks) st[nt] = MFMA16(lds_frag(kt_l + ((nt * 16 + r) * KST + ks * 32 + q * 8) * 2), qf[ks], st[nt]); }
            float mx = fmaxf(fmaxf(fmaxf(st[0][0], st[0][1]), fmaxf(st[0][2], st[0][3])), fmaxf(fmaxf(st[1][0], st[1][1]), fmaxf(st[1][2], st[1][3])));
            mx = fmaxf(mx, fmaxf(fmaxf(fmaxf(st[2][0], st[2][1]), fmaxf(st[2][2], st[2][3])), fmaxf(fmaxf(st[3][0], st[3][1]), fmaxf(st[3][2], st[3][3]))));
            mx = fmaxf(mx, bperm_f(mx, lane ^ 16)); mx = fmaxf(mx, bperm_f(mx, lane ^ 32));
            const float mn = fmaxf(mrow, mx), alpha = __builtin_amdgcn_exp2f(mrow - mn); mrow = mn; float rs = 0.f;
#pragma unroll
            for (int nt = 0; nt < 4; ++nt)
#pragma unroll
                for (int i = 0; i < 4; ++i) { const float p = __builtin_amdgcn_exp2f(st[nt][i] - mn); st[nt][i] = p; rs += p; }
            lrow = lrow * alpha + rs;
            bf16x8 pf[2];
#pragma unroll
            for (int ks2 = 0; ks2 < 2; ++ks2) pf[ks2] = __builtin_bit_cast(bf16x8, pg8::pack8(st[2 * ks2], st[2 * ks2 + 1]));
#pragma unroll
            for (int d = 0; d < NVT; ++d) { o[d] = o[d] * alpha;
#pragma unroll
                for (int ks2 = 0; ks2 < 2; ++ks2) { const LAS unsigned char* vp = vt_l + ((d * 16 + r) * 72 + ks2 * 32 + q * 4) * 2;
                    const u32x2 v0 = *(const LAS u32x2*)vp, v1 = *(const LAS u32x2*)(vp + 32);
                    const u32x4 vv = {v0.x, v0.y, v1.x, v1.y};
                    o[d] = MFMA16(__builtin_bit_cast(bf16x8, vv), pf[ks2], o[d]); } }
        }
        if (kt + 1 < nkt) {
            if constexpr (NST == 1) lds_barrier();
            ATT_STORE((NST == 2) ? ((kt + 1) & 1) : 0);
        }
        lds_barrier();
    }
#undef ATT_LOAD
#undef ATT_STORE
    { float ls = lrow; ls += bperm_f(ls, lane ^ 16); ls += bperm_f(ls, lane ^ 32); const float inv = 1.f / ls; bf16_t* yp = Y + (size_t)(wid * 16 + r) * ldy + q * 4;
#pragma unroll
        for (int d = 0; d < NVT; ++d) { u32x2 w; w.x = pk2(o[d][0] * inv, o[d][1] * inv); w.y = pk2(o[d][2] * inv, o[d][3] * inv); *(u32x2*)(yp + d * 16) = w; } }
}

struct LayerP {
    const float* ssd_conv_w; const float* ssd_conv_b; const float* ssd_dt_bias; const float* ssd_a_log; const float* ssd_d; const float* ssd_norm_g;
    const float* gdn_conv_w; const float* gdn_dt_bias; const float* gdn_a_log; const float* gdn_norm_g;
};
__device__ __forceinline__ void gdn_prep_item(LAS unsigned char* lds, const bf16_t* cols, const LayerP& P, bf16_t* GP, float* gdec, int item) {
    const int tid = tid_o(), wid = tid >> 6, lane = tid & 63, r = lane & 15, q = lane >> 4;
    const int h = item & 3, c = (item >> 2) & 63, b = item >> 8;
    LAS bf16_t* RAW = (LAS bf16_t*)lds;
    LAS float* QF = (LAS float*)(lds + 25856);
    LAS float* KF = QF + 64 * 65; LAS float* VF = KF + 64 * 65;
    LAS unsigned char* QB = lds + 75776; LAS unsigned char* KB = QB + 9216; LAS unsigned char* KBB = KB + 9216;
    LAS float* MM = (LAS float*)(lds + 103424);
    LAS float* BETA = (LAS float*)(lds + 120832); LAS float* GC = BETA + 64;
    const size_t tok0 = (size_t)b * SEQ + (size_t)c * 64;
    bf16_t* gp = GP + (size_t)item * (5 * 4096);
    bf16_t* gU = gp; bf16_t* gW = gp + 4096; bf16_t* gQK = gp + 8192; bf16_t* gQD = gp + 12288; bf16_t* gKDT = gp + 16384;
    lds_barrier();
    for (int i = tid; i < 67 * 24; i += NT) { const int rr = i / 24, rem = i % 24, p = rem >> 3, pc = rem & 7; const int t = c * 64 - 3 + rr;
        u32x4 v = (u32x4){0u, 0u, 0u, 0u};
        if (t >= 0) v = *(const u32x4*)(cols + ((size_t)b * SEQ + t) * LDC + GDN_QKV + p * 256 + h * 64 + pc * 8);
        *(LAS u32x4*)(RAW + rr * 192 + p * 64 + pc * 8) = v; }
    if (wid == 7) { const size_t tok = tok0 + lane;
        const float braw = bf2f(cols[tok * LDC + GDN_B + h]), araw = bf2f(cols[tok * LDC + GDN_A + h]);
        const float beta = __builtin_amdgcn_rcpf(1.f + __expf(-braw));
        float g = -__expf(P.gdn_a_log[h]) * softplus_f(araw + P.gdn_dt_bias[h]);
#pragma unroll
        for (int o = 1; o < 64; o <<= 1) { const float t = bperm_f(g, lane - o); if (lane >= o) g += t; }
        BETA[lane] = beta; GC[lane] = g; }
    lds_barrier();
    if (tid < 384) { const int ch = tid % 192, l0 = tid / 192, p = ch >> 6, d = ch & 63; const int C = p * 256 + h * 64 + d;
        const float w0 = P.gdn_conv_w[C], w1 = P.gdn_conv_w[768 + C], w2 = P.gdn_conv_w[1536 + C], w3 = P.gdn_conv_w[2304 + C];
        LAS float* F = QF + p * (64 * 65);
        const int lb = l0 * 32; float x0 = bf2f(RAW[lb * 192 + ch]), x1 = bf2f(RAW[(lb + 1) * 192 + ch]), x2 = bf2f(RAW[(lb + 2) * 192 + ch]);
#pragma unroll 4
        for (int j = 0; j < 32; ++j) { const int l = lb + j; const float x3 = bf2f(RAW[(l + 3) * 192 + ch]);
            F[l * 65 + d] = silu_f(w0 * x0 + w1 * x1 + w2 * x2 + w3 * x3); x0 = x1; x1 = x2; x2 = x3; } }
    lds_barrier();
    { const int row = tid >> 2, sub = tid & 3, which = row >> 6, l = row & 63; LAS float* F = (which ? KF : QF) + l * 65 + sub * 16; float s = 0.f;
#pragma unroll
        for (int j = 0; j < 16; ++j) s += F[j] * F[j];
        s += dppf<0xB1>(s); s += dppf<0x4E>(s);
        const float rn = __builtin_amdgcn_rsqf(s + EPS) * (which ? 1.f : 0.125f);
#pragma unroll
        for (int j = 0; j < 16; ++j) F[j] *= rn; }
    lds_barrier();
    { const int l = tid >> 3, d0 = (tid & 7) * 8; const float beta = BETA[l], eg = __expf(GC[l]);
        f32x4 qa, qb, ka, kb;
#pragma unroll
        for (int j = 0; j < 4; ++j) { qa[j] = QF[l * 65 + d0 + j]; qb[j] = QF[l * 65 + d0 + 4 + j]; ka[j] = KF[l * 65 + d0 + j]; kb[j] = KF[l * 65 + d0 + 4 + j]; }
        *(LAS u32x4*)(QB + (l * 72 + d0) * 2) = pg8::pack8(qa, qb);
        *(LAS u32x4*)(KB + (l * 72 + d0) * 2) = pg8::pack8(ka, kb);
        *(LAS u32x4*)(KBB + (l * 72 + d0) * 2) = pg8::pack8(ka * beta, kb * beta);
        *(u32x4*)(gQD + l * 64 + d0) = pg8::pack8(qa * eg, qb * eg);
        const int d = tid >> 3, l0 = (tid & 7) * 8; const float gl = GC[63]; f32x4 ta, tb;
#pragma unroll
        for (int j = 0; j < 4; ++j) { ta[j] = KF[(l0 + j) * 65 + d] * __expf(gl - GC[l0 + j]); tb[j] = KF[(l0 + 4 + j) * 65 + d] * __expf(gl - GC[l0 + 4 + j]); }
        *(u32x4*)(gKDT + d * 64 + l0) = pg8::pack8(ta, tb);
        if (tid == 0) gdec[item] = __expf(gl); }
    lds_barrier();
    { const int lt = wid >> 1;
#pragma unroll
        for (int t = 0; t < 2; ++t) { const int st = (wid & 1) * 2 + t; f32x4 akk = (f32x4){0.f, 0.f, 0.f, 0.f}, aqk = akk;
#pragma unroll
            for (int ks = 0; ks < 2; ++ks) { const bf16x8 bfr = lds_frag(KB + ((st * 16 + r) * 72 + ks * 32 + q * 8) * 2);
                akk = MFMA16(lds_frag(KBB + ((lt * 16 + r) * 72 + ks * 32 + q * 8) * 2), bfr, akk);
                aqk = MFMA16(lds_frag(QB + ((lt * 16 + r) * 72 + ks * 32 + q * 8) * 2), bfr, aqk); }
            const int s = st * 16 + r; const float gs = GC[s]; f32x4 mmv;
#pragma unroll
            for (int i = 0; i < 4; ++i) { const int l = lt * 16 + q * 4 + i; const float gam = (s <= l) ? __expf(GC[l] - gs) : 0.f;
                mmv[i] = (s < l) ? akk[i] * gam : 0.f;
                gQK[l * 64 + s] = (bf16_t)f2bf((s <= l) ? aqk[i] * gam : 0.f); }
            *(LAS f32x4*)(MM + s * 68 + lt * 16 + q * 4) = mmv; } }
    lds_barrier();
    { const int col = tid >> 2, k = tid & 3, j = col & 63; const bool isw = col >= 64; LAS float* SRC = isw ? KF : VF; LAS float* XL = (LAS float*)lds;
        bf16_t* dst = (isw ? gW : gU) + j;
#pragma unroll
        for (int bI = 0; bI < 4; ++bI) { const int lb = bI * 16 + 4 * k; float acc[4];
#pragma unroll
            for (int e = 0; e < 4; ++e) { const int l = lb + e; float a = SRC[l * 65 + j] * BETA[l]; if (isw) a *= __expf(GC[l]); acc[e] = a; }
            f32x4 dg[16];
#pragma unroll
            for (int i = 0; i < 16; ++i) dg[i] = *(const LAS f32x4*)(MM + (bI * 16 + i) * 68 + lb);
#pragma unroll 4
            for (int s = 0; s < bI * 16; ++s) { const float xs = XL[s * 128 + col]; const f32x4 mv = *(const LAS f32x4*)(MM + s * 68 + lb);
#pragma unroll
                for (int e = 0; e < 4; ++e) acc[e] -= mv[e] * xs; }
#pragma unroll
            for (int i = 0; i < 16; ++i) { const float own = acc[i & 3];
                const float xv = (i / 4 == 0) ? dppf<0x00>(own) : (i / 4 == 1) ? dppf<0x55>(own) : (i / 4 == 2) ? dppf<0xAA>(own) : dppf<0xFF>(own);
#pragma unroll
                for (int e = 0; e < 4; ++e) acc[e] -= dg[i][e] * xv; }
#pragma unroll
            for (int e = 0; e < 4; ++e) { const int l = lb + e; if (bI < 3) XL[l * 128 + col] = acc[e]; dst[l * 64] = (bf16_t)f2bf(acc[e]); } } }
    lds_barrier();
}

__device__ __forceinline__ void gdn_scan_item(LAS unsigned char* lds, const bf16_t* cols, const LayerP& P, const bf16_t* GP, const float* gdec, bf16_t* Y, int item) {
    const int tid = tid_o(), wid = tid >> 6, lane = tid & 63, r = lane & 15, q = lane >> 4;
    const int h = item & 3, b = item >> 2;
    constexpr int MB = 9216, DBB = 5 * MB;
    LAS unsigned char* DB = lds; LAS unsigned char* ST = lds + 2 * DBB; LAS unsigned char* VN = ST + MB; LAS float* OB = (LAS float*)(VN + MB);
    const int lt = wid >> 1, vt0 = (wid & 1) * 2;
    const int prow = tid >> 3, pcol = (tid & 7) * 8;
    f32x4 sacc[2] = {(f32x4){0.f, 0.f, 0.f, 0.f}, (f32x4){0.f, 0.f, 0.f, 0.f}};
    __syncthreads();
    for (int i = tid; i < MB / 4; i += NT) ((LAS unsigned*)ST)[i] = 0u;
    u32x4 pre[2][5];
    { const bf16_t* gp = GP + (size_t)((b * 64 + 0) * 4 + h) * (5 * 4096);
#pragma unroll
        for (int m = 0; m < 5; ++m) pre[0][m] = *(const u32x4*)(gp + m * 4096 + prow * 64 + pcol);
#pragma unroll
        for (int m = 0; m < 5; ++m) pre[1][m] = *(const u32x4*)(gp + 5 * 4096 * 4 + m * 4096 + prow * 64 + pcol);
#pragma unroll
        for (int m = 0; m < 5; ++m) *(LAS u32x4*)(DB + m * MB + (prow * 72 + pcol) * 2) = pre[0][m]; }
    __syncthreads();
    const int fl = tid >> 3, fv0 = (tid & 7) * 8;
    const f32x4 ga = *(const f32x4*)(P.gdn_norm_g + fv0), gb = *(const f32x4*)(P.gdn_norm_g + fv0 + 4);
    u32x4 zn = *(const u32x4*)(cols + ((size_t)b * SEQ + fl) * LDC + GDN_Z + h * 64 + fv0);
    float decn = gdec[(b * 64 + 0) * 4 + h];
    for (int c2 = 0; c2 < 64; c2 += 2) {
#pragma unroll
      for (int u = 0; u < 2; ++u) { const int c = c2 + u;
        const u32x4 zz = zn; const float dec = decn;
        if (c + 1 < 64) { zn = *(const u32x4*)(cols + ((size_t)b * SEQ + (c + 1) * 64 + fl) * LDC + GDN_Z + h * 64 + fv0); decn = gdec[(b * 64 + c + 1) * 4 + h]; }
        LAS unsigned char* cur = DB + u * DBB; LAS unsigned char* nxt = DB + (u ^ 1) * DBB;
        LAS unsigned char* mU = cur; LAS unsigned char* mW = cur + MB; LAS unsigned char* mQK = cur + 2 * MB; LAS unsigned char* mQD = cur + 3 * MB; LAS unsigned char* mKDT = cur + 4 * MB;
        if (c + 2 < 64) { const bf16_t* gp = GP + (size_t)((b * 64 + c + 2) * 4 + h) * (5 * 4096);
#pragma unroll
            for (int m = 0; m < 5; ++m) pre[u][m] = *(const u32x4*)(gp + m * 4096 + prow * 64 + pcol); }
        f32x4 ao[2];
#pragma unroll
        for (int t = 0; t < 2; ++t) { const int vt = vt0 + t; f32x4 aws = (f32x4){0.f, 0.f, 0.f, 0.f}; ao[t] = aws;
#pragma unroll
            for (int ks = 0; ks < 2; ++ks) { const bf16x8 bfr = lds_frag(ST + ((vt * 16 + r) * 72 + ks * 32 + q * 8) * 2);
                aws = MFMA16(lds_frag(mW + ((lt * 16 + r) * 72 + ks * 32 + q * 8) * 2), bfr, aws);
                ao[t] = MFMA16(lds_frag(mQD + ((lt * 16 + r) * 72 + ks * 32 + q * 8) * 2), bfr, ao[t]); }
            f32x4 vn;
#pragma unroll
            for (int i = 0; i < 4; ++i) vn[i] = bf2f(*(const LAS bf16_t*)(mU + ((lt * 16 + q * 4 + i) * 72 + vt * 16 + r) * 2)) - aws[i];
            u32x2 w2; w2.x = pk2(vn[0], vn[1]); w2.y = pk2(vn[2], vn[3]);
            *(LAS u32x2*)(VN + ((vt * 16 + r) * 72 + lt * 16 + q * 4) * 2) = w2; }
        lds_barrier();
#pragma unroll
        for (int t = 0; t < 2; ++t) { const int vt = vt0 + t; sacc[t] = sacc[t] * dec;
#pragma unroll
            for (int ks = 0; ks < 2; ++ks) { const bf16x8 bfr = lds_frag(VN + ((vt * 16 + r) * 72 + ks * 32 + q * 8) * 2);
                ao[t] = MFMA16(lds_frag(mQK + ((lt * 16 + r) * 72 + ks * 32 + q * 8) * 2), bfr, ao[t]);
                sacc[t] = MFMA16(lds_frag(mKDT + ((lt * 16 + r) * 72 + ks * 32 + q * 8) * 2), bfr, sacc[t]); }
#pragma unroll
            for (int i = 0; i < 4; ++i) OB[(lt * 16 + q * 4 + i) * 68 + vt * 16 + r] = ao[t][i];
            u32x2 w2; w2.x = pk2(sacc[t][0], sacc[t][1]); w2.y = pk2(sacc[t][2], sacc[t][3]);
            *(LAS u32x2*)(ST + ((vt * 16 + r) * 72 + lt * 16 + q * 4) * 2) = w2; }
        if (c + 1 < 64) {
#pragma unroll
            for (int m = 0; m < 5; ++m) *(LAS u32x4*)(nxt + m * MB + (prow * 72 + pcol) * 2) = pre[u ^ 1][m]; }
        lds_barrier();
        { const int l = tid >> 3, v0 = (tid & 7) * 8; const size_t tok = (size_t)b * SEQ + c * 64 + l;
            const f32x4 oa = *(const LAS f32x4*)(OB + l * 68 + v0), ob = *(const LAS f32x4*)(OB + l * 68 + v0 + 4);
            float s = 0.f;
#pragma unroll
            for (int j = 0; j < 4; ++j) s += oa[j] * oa[j] + ob[j] * ob[j];
            s = row8_sum(s);
            const float rs = __builtin_amdgcn_rsqf(s * (1.f / 64.f) + EPS);
            f32x4 ra, rb;
            ra[0] = oa[0] * rs * ga[0] * silu_f(bflo(zz.x)); ra[1] = oa[1] * rs * ga[1] * silu_f(bfhi(zz.x));
            ra[2] = oa[2] * rs * ga[2] * silu_f(bflo(zz.y)); ra[3] = oa[3] * rs * ga[3] * silu_f(bfhi(zz.y));
            rb[0] = ob[0] * rs * gb[0] * silu_f(bflo(zz.z)); rb[1] = ob[1] * rs * gb[1] * silu_f(bfhi(zz.z));
            rb[2] = ob[2] * rs * gb[2] * silu_f(bflo(zz.w)); rb[3] = ob[3] * rs * gb[3] * silu_f(bfhi(zz.w));
            *(u32x4*)(Y + tok * 1024 + 768 + h * 64 + v0) = pg8::pack8(ra, rb); }
      }
    }
    __syncthreads();
}

__device__ __forceinline__ void ssd_scan_item(LAS unsigned char* lds, const bf16_t* cols, const LayerP& P, bf16_t* Y, float* ssdp, int item) {
    const int tid = tid_o(), wid = tid >> 6, lane = tid & 63, r = lane & 15, q = lane >> 4;
    const int hd = item & 7, b = item >> 3, g = hd >> 2;
    constexpr int MB = 9216;
    LAS bf16_t* RAW = (LAS bf16_t*)lds;
    LAS unsigned char* XT = lds + 25856; LAS unsigned char* BM_ = XT + MB; LAS unsigned char* BTS = BM_ + MB; LAS unsigned char* CM = BTS + MB;
    LAS unsigned char* HC = CM + MB; LAS unsigned char* GM = HC + MB;
    LAS float* DT = (LAS float*)(GM + MB); LAS float* AC = DT + 64;
    const int lt = wid >> 1, pt0 = (wid & 1) * 2;
    const float a_h = -__expf(P.ssd_a_log[hd]), dtb = P.ssd_dt_bias[hd], dsk = P.ssd_d[hd];
    const int ch = tid % 192, l0 = tid / 192;
    int cc;
    if (ch < 64) cc = hd * 64 + ch; else if (ch < 128) cc = 512 + g * 64 + (ch - 64); else cc = 640 + g * 64 + (ch - 128);
    float w0 = 0.f, w1 = 0.f, w2 = 0.f, w3 = 0.f, cb = 0.f;
    if (tid < 384) { w0 = P.ssd_conv_w[cc]; w1 = P.ssd_conv_w[768 + cc]; w2 = P.ssd_conv_w[1536 + cc]; w3 = P.ssd_conv_w[2304 + cc]; cb = P.ssd_conv_b[cc]; }
    f32x4 hacc[2] = {(f32x4){0.f, 0.f, 0.f, 0.f}, (f32x4){0.f, 0.f, 0.f, 0.f}};
    __syncthreads();
    for (int i = tid; i < MB / 4; i += NT) ((LAS unsigned*)HC)[i] = 0u;
    u32x4 pre[4];
#define SSD_LOAD_RAW(cidx) do { _Pragma("unroll") for (int k = 0; k < 4; ++k) { const int i = tid + k * NT; pre[k] = (u32x4){0u, 0u, 0u, 0u}; \
        if (i < 67 * 24) { const int rr = i / 24, rem = i % 24, p = rem >> 3, pc = rem & 7; const int t = (cidx) * 64 - 3 + rr; \
            const int colb = (p == 0) ? (SSD_XBC + hd * 64) : (p == 1 ? SSD_XBC + 512 + g * 64 : SSD_XBC + 640 + g * 64); \
            if (t >= 0) pre[k] = *(const u32x4*)(cols + ((size_t)b * SEQ + t) * LDC + colb + pc * 8); } } } while (0)
#define SSD_STORE_RAW() do { _Pragma("unroll") for (int k = 0; k < 4; ++k) { const int i = tid + k * NT; \
        if (i < 67 * 24) { const int rr = i / 24, rem = i % 24, p = rem >> 3, pc = rem & 7; *(LAS u32x4*)(RAW + rr * 192 + p * 64 + pc * 8) = pre[k]; } } } while (0)
    SSD_LOAD_RAW(0); SSD_STORE_RAW();
    float dtrn = 0.f; if (wid == 6) dtrn = bf2f(cols[((size_t)b * SEQ + lane) * LDC + SSD_DT + hd]);
    bf16_t zn[8];
#pragma unroll
    for (int t = 0; t < 2; ++t)
#pragma unroll
        for (int i = 0; i < 4; ++i) zn[t * 4 + i] = cols[((size_t)b * SEQ + lt * 16 + q * 4 + i) * LDC + SSD_Z + hd * 64 + (pt0 + t) * 16 + r];
    __syncthreads();
    for (int c = 0; c < 64; ++c) {
        const size_t tok0 = (size_t)b * SEQ + (size_t)c * 64;
        if (c + 1 < 64) SSD_LOAD_RAW(c + 1);
        bf16_t zc[8];
#pragma unroll
        for (int k = 0; k < 8; ++k) zc[k] = zn[k];
        if (c + 1 < 64) {
#pragma unroll
            for (int t = 0; t < 2; ++t)
#pragma unroll
                for (int i = 0; i < 4; ++i) zn[t * 4 + i] = cols[(tok0 + 64 + lt * 16 + q * 4 + i) * LDC + SSD_Z + hd * 64 + (pt0 + t) * 16 + r]; }
        if (tid < 384) {
            const int lb = l0 * 32; float x0 = bf2f(RAW[lb * 192 + ch]), x1 = bf2f(RAW[(lb + 1) * 192 + ch]), x2 = bf2f(RAW[(lb + 2) * 192 + ch]);
#pragma unroll 4
            for (int j = 0; j < 32; ++j) { const int l = lb + j; const float x3 = bf2f(RAW[(l + 3) * 192 + ch]);
                const float y = silu_f(cb + w0 * x0 + w1 * x1 + w2 * x2 + w3 * x3); x0 = x1; x1 = x2; x2 = x3;
                const bf16_t yb = (bf16_t)f2bf(y);
                if (ch < 64) *(LAS bf16_t*)(XT + (ch * 72 + l) * 2) = yb;
                else if (ch < 128) *(LAS bf16_t*)(BM_ + (l * 72 + ch - 64) * 2) = yb;
                else *(LAS bf16_t*)(CM + (l * 72 + ch - 128) * 2) = yb; }
        } else if (wid == 6) {
            const float dt = softplus_f(dtrn + dtb); float ac = dt * a_h;
#pragma unroll
            for (int o = 1; o < 64; o <<= 1) { const float t = bperm_f(ac, lane - o); if (lane >= o) ac += t; }
            DT[lane] = dt; AC[lane] = ac;
            if (c + 1 < 64) dtrn = bf2f(cols[(tok0 + 64 + lane) * LDC + SSD_DT + hd]); }
        __syncthreads();
        const float ac63 = AC[63];
        { const int n = tid >> 3, lb = (tid & 7) * 8; f32x4 ta, tb;
#pragma unroll
            for (int j = 0; j < 4; ++j) { ta[j] = bf2f(*(const LAS bf16_t*)(BM_ + ((lb + j) * 72 + n) * 2)) * DT[lb + j] * __expf(ac63 - AC[lb + j]);
                tb[j] = bf2f(*(const LAS bf16_t*)(BM_ + ((lb + 4 + j) * 72 + n) * 2)) * DT[lb + 4 + j] * __expf(ac63 - AC[lb + 4 + j]); }
            *(LAS u32x4*)(BTS + (n * 72 + lb) * 2) = pg8::pack8(ta, tb); }
#pragma unroll
        for (int t = 0; t < 2; ++t) { const int st = pt0 + t; f32x4 a = (f32x4){0.f, 0.f, 0.f, 0.f};
#pragma unroll
            for (int ks = 0; ks < 2; ++ks) a = MFMA16(lds_frag(CM + ((lt * 16 + r) * 72 + ks * 32 + q * 8) * 2), lds_frag(BM_ + ((st * 16 + r) * 72 + ks * 32 + q * 8) * 2), a);
            const int s = st * 16 + r; const float as = AC[s], ds = DT[s];
#pragma unroll
            for (int i = 0; i < 4; ++i) { const int l = lt * 16 + q * 4 + i; const float gv = (s <= l) ? a[i] * __expf(AC[l] - as) * ds : 0.f;
                *(LAS bf16_t*)(GM + (l * 72 + s) * 2) = (bf16_t)f2bf(gv); } }
        __syncthreads();
        float ssq[4] = {0.f, 0.f, 0.f, 0.f};
#pragma unroll
        for (int t = 0; t < 2; ++t) { const int pt = pt0 + t; f32x4 yd = (f32x4){0.f, 0.f, 0.f, 0.f}, yo = yd;
#pragma unroll
            for (int ks = 0; ks < 2; ++ks) {
                yd = MFMA16(lds_frag(GM + ((lt * 16 + r) * 72 + ks * 32 + q * 8) * 2), lds_frag(XT + ((pt * 16 + r) * 72 + ks * 32 + q * 8) * 2), yd);
                yo = MFMA16(lds_frag(CM + ((lt * 16 + r) * 72 + ks * 32 + q * 8) * 2), lds_frag(HC + ((pt * 16 + r) * 72 + ks * 32 + q * 8) * 2), yo); }
            const int p = pt * 16 + r; const u32x2 xw = *(const LAS u32x2*)(XT + (p * 72 + lt * 16 + q * 4) * 2);
            const float xs4[4] = {bflo(xw.x), bfhi(xw.x), bflo(xw.y), bfhi(xw.y)};
#pragma unroll
            for (int i = 0; i < 4; ++i) { const int l = lt * 16 + q * 4 + i; const size_t tok = tok0 + l;
                float y = yd[i] + __expf(AC[l]) * yo[i] + dsk * xs4[i];
                y *= silu_f(bf2f(zc[t * 4 + i]));
                ssq[i] += y * y;
                Y[tok * 1024 + hd * 64 + p] = (bf16_t)f2bf(y); } }
#pragma unroll
        for (int i = 0; i < 4; ++i) { float s = ssq[i]; s += __shfl_xor(s, 1); s += __shfl_xor(s, 2); s += __shfl_xor(s, 4); s += __shfl_xor(s, 8);
            if (r == 0) ssdp[(tok0 + lt * 16 + q * 4 + i) * 16 + hd * 2 + (wid & 1)] = s; }
        { const float dec = __expf(ac63);
#pragma unroll
            for (int t = 0; t < 2; ++t) { const int pt = pt0 + t; hacc[t] = hacc[t] * dec;
#pragma unroll
                for (int ks = 0; ks < 2; ++ks) hacc[t] = MFMA16(lds_frag(BTS + ((lt * 16 + r) * 72 + ks * 32 + q * 8) * 2), lds_frag(XT + ((pt * 16 + r) * 72 + ks * 32 + q * 8) * 2), hacc[t]); } }
        __syncthreads();
#pragma unroll
        for (int t = 0; t < 2; ++t) { const int pt = pt0 + t; u32x2 w2; w2.x = pk2(hacc[t][0], hacc[t][1]); w2.y = pk2(hacc[t][2], hacc[t][3]);
            *(LAS u32x2*)(HC + ((pt * 16 + r) * 72 + lt * 16 + q * 4) * 2) = w2; }
        if (c + 1 < 64) SSD_STORE_RAW();
        __syncthreads();
    }
#undef SSD_LOAD_RAW
#undef SSD_STORE_RAW
}

__device__ __forceinline__ void ssd_prep_range(LAS unsigned char* lds, const bf16_t* cols, const LayerP& P, bf16_t* Y, bf16_t* SST, float* SAC, bf16_t* CMS, int b, int hd, int c0, int c1) {
    const int tid = tid_o(), wid = tid >> 6, lane = tid & 63, r = lane & 15, q = lane >> 4;
    const int g = hd >> 2;
    constexpr int MB = 9216;
    LAS bf16_t* RAW = (LAS bf16_t*)lds;
    LAS unsigned char* XT = lds + 25856; LAS unsigned char* BM_ = XT + MB; LAS unsigned char* BTS = BM_ + MB; LAS unsigned char* CM = BTS + MB; LAS unsigned char* GM = CM + MB;
    LAS float* DT = (LAS float*)(GM + MB); LAS float* AC = DT + 64;
    const int lt = wid >> 1, pt0 = (wid & 1) * 2;
    const float a_h = -__expf(P.ssd_a_log[hd]), dtb = P.ssd_dt_bias[hd], dsk = P.ssd_d[hd];
    const int ch = tid % 192, l0 = tid / 192;
    int cc;
    if (ch < 64) cc = hd * 64 + ch; else if (ch < 128) cc = 512 + g * 64 + (ch - 64); else cc = 640 + g * 64 + (ch - 128);
    float w0 = 0.f, w1 = 0.f, w2 = 0.f, w3 = 0.f, cb = 0.f;
    if (tid < 384) { w0 = P.ssd_conv_w[cc]; w1 = P.ssd_conv_w[768 + cc]; w2 = P.ssd_conv_w[1536 + cc]; w3 = P.ssd_conv_w[2304 + cc]; cb = P.ssd_conv_b[cc]; }
    u32x4 pre[4];
#define SSD_LOAD_RAW(cidx) do { _Pragma("unroll") for (int k = 0; k < 4; ++k) { const int i = tid + k * NT; pre[k] = (u32x4){0u, 0u, 0u, 0u}; \
        if (i < 67 * 24) { const int rr = i / 24, rem = i % 24, p = rem >> 3, pc = rem & 7; const int t = (cidx) * 64 - 3 + rr; \
            const int colb = (p == 0) ? (SSD_XBC + hd * 64) : (p == 1 ? SSD_XBC + 512 + g * 64 : SSD_XBC + 640 + g * 64); \
            if (t >= 0) pre[k] = *(const u32x4*)(cols + ((size_t)b * SEQ + t) * LDC + colb + pc * 8); } } } while (0)
#define SSD_STORE_RAW() do { _Pragma("unroll") for (int k = 0; k < 4; ++k) { const int i = tid + k * NT; \
        if (i < 67 * 24) { const int rr = i / 24, rem = i % 24, p = rem >> 3, pc = rem & 7; *(LAS u32x4*)(RAW + rr * 192 + p * 64 + pc * 8) = pre[k]; } } } while (0)
    __syncthreads();
    SSD_LOAD_RAW(c0); SSD_STORE_RAW();
    float dtrn = 0.f; if (wid == 6) dtrn = bf2f(cols[((size_t)b * SEQ + c0 * 64 + lane) * LDC + SSD_DT + hd]);
    __syncthreads();
    for (int c = c0; c < c1; ++c) {
        const size_t tok0 = (size_t)b * SEQ + (size_t)c * 64; const size_t it = (size_t)(b * 8 + hd) * 64 + c;
        if (c + 1 < c1) SSD_LOAD_RAW(c + 1);
        if (tid < 384) {
            const int lb = l0 * 32; float x0 = bf2f(RAW[lb * 192 + ch]), x1 = bf2f(RAW[(lb + 1) * 192 + ch]), x2 = bf2f(RAW[(lb + 2) * 192 + ch]);
#pragma unroll 4
            for (int j = 0; j < 32; ++j) { const int l = lb + j; const float x3 = bf2f(RAW[(l + 3) * 192 + ch]);
                const float y = silu_f(cb + w0 * x0 + w1 * x1 + w2 * x2 + w3 * x3); x0 = x1; x1 = x2; x2 = x3;
                const bf16_t yb = (bf16_t)f2bf(y);
                if (ch < 64) *(LAS bf16_t*)(XT + (ch * 72 + l) * 2) = yb;
                else if (ch < 128) *(LAS bf16_t*)(BM_ + (l * 72 + ch - 64) * 2) = yb;
                else *(LAS bf16_t*)(CM + (l * 72 + ch - 128) * 2) = yb; }
        } else if (wid == 6) {
            const float dt = softplus_f(dtrn + dtb); float ac = dt * a_h;
#pragma unroll
            for (int o = 1; o < 64; o <<= 1) { const float t = bperm_f(ac, lane - o); if (lane >= o) ac += t; }
            DT[lane] = dt; AC[lane] = ac; SAC[it * 64 + lane] = ac;
            if (c + 1 < c1) dtrn = bf2f(cols[(tok0 + 64 + lane) * LDC + SSD_DT + hd]); }
        lds_barrier();
        const float ac63 = AC[63];
        { const int n = tid >> 3, lb = (tid & 7) * 8; f32x4 ta, tb;
#pragma unroll
            for (int j = 0; j < 4; ++j) { ta[j] = bf2f(*(const LAS bf16_t*)(BM_ + ((lb + j) * 72 + n) * 2)) * DT[lb + j] * __expf(ac63 - AC[lb + j]);
                tb[j] = bf2f(*(const LAS bf16_t*)(BM_ + ((lb + 4 + j) * 72 + n) * 2)) * DT[lb + 4 + j] * __expf(ac63 - AC[lb + 4 + j]); }
            *(LAS u32x4*)(BTS + (n * 72 + lb) * 2) = pg8::pack8(ta, tb);
            if ((hd & 3) == 0) *(u32x4*)(CMS + ((size_t)((b * 64 + c) * 2 + g)) * 4096 + n * 64 + lb) = *(const LAS u32x4*)(CM + (n * 72 + lb) * 2); }
#pragma unroll
        for (int t = 0; t < 2; ++t) { const int st = pt0 + t; f32x4 a = (f32x4){0.f, 0.f, 0.f, 0.f};
#pragma unroll
            for (int ks = 0; ks < 2; ++ks) a = MFMA16(lds_frag(CM + ((lt * 16 + r) * 72 + ks * 32 + q * 8) * 2), lds_frag(BM_ + ((st * 16 + r) * 72 + ks * 32 + q * 8) * 2), a);
            const int s_ = st * 16 + r; const float as = AC[s_], ds = DT[s_];
#pragma unroll
            for (int i = 0; i < 4; ++i) { const int l = lt * 16 + q * 4 + i; const float gv = (s_ <= l) ? a[i] * __expf(AC[l] - as) * ds : 0.f;
                *(LAS bf16_t*)(GM + (l * 72 + s_) * 2) = (bf16_t)f2bf(gv); } }
        lds_barrier();
#pragma unroll
        for (int t = 0; t < 2; ++t) { const int pt = pt0 + t; f32x4 yd = (f32x4){0.f, 0.f, 0.f, 0.f}, sc = yd;
#pragma unroll
            for (int ks = 0; ks < 2; ++ks) {
                const bf16x8 xf = lds_frag(XT + ((pt * 16 + r) * 72 + ks * 32 + q * 8) * 2);
                yd = MFMA16(lds_frag(GM + ((lt * 16 + r) * 72 + ks * 32 + q * 8) * 2), xf, yd);
                sc = MFMA16(lds_frag(BTS + ((lt * 16 + r) * 72 + ks * 32 + q * 8) * 2), xf, sc); }
            const int p = pt * 16 + r; const u32x2 xw = *(const LAS u32x2*)(XT + (p * 72 + lt * 16 + q * 4) * 2);
            const float xs4[4] = {bflo(xw.x), bfhi(xw.x), bflo(xw.y), bfhi(xw.y)};
#pragma unroll
            for (int i = 0; i < 4; ++i) Y[(tok0 + lt * 16 + q * 4 + i) * 1024 + hd * 64 + p] = (bf16_t)f2bf(yd[i] + dsk * xs4[i]);
            u32x2 w2; w2.x = pk2(sc[0], sc[1]); w2.y = pk2(sc[2], sc[3]);
            *(u32x2*)(SST + it * 4096 + p * 64 + lt * 16 + q * 4) = w2; }
        if (c + 1 < c1) SSD_STORE_RAW();
        lds_barrier();
    }
#undef SSD_LOAD_RAW
#undef SSD_STORE_RAW
}
__device__ __forceinline__ void ssd_state_scan_item(LAS unsigned char* lds, bf16_t* SST, const float* SAC, int item) {
    const int tid = tid_o(); LAS float* DEC = (LAS float*)lds;
    __syncthreads();
    if (tid < 64) DEC[tid] = __expf(SAC[((size_t)item * 64 + tid) * 64 + 63]);
    __syncthreads();
    bf16_t* base = SST + (size_t)item * 64 * 4096 + tid * 8;
    f32x4 ha = (f32x4){0.f, 0.f, 0.f, 0.f}, hb2 = ha;
    u32x4 sv[4];
#pragma unroll
    for (int k = 0; k < 4; ++k) sv[k] = *(const u32x4*)(base + (size_t)k * 4096);
    for (int c4 = 0; c4 < 64; c4 += 4) {
#pragma unroll
        for (int k = 0; k < 4; ++k) { const int c = c4 + k; const u32x4 w = sv[k];
            if (c + 4 < 64) sv[k] = *(const u32x4*)(base + (size_t)(c + 4) * 4096);
            *(u32x4*)(base + (size_t)c * 4096) = pg8::pack8(ha, hb2);
            const float d = DEC[c];
            ha[0] = ha[0] * d + bflo(w.x); ha[1] = ha[1] * d + bfhi(w.x); ha[2] = ha[2] * d + bflo(w.y); ha[3] = ha[3] * d + bfhi(w.y);
            hb2[0] = hb2[0] * d + bflo(w.z); hb2[1] = hb2[1] * d + bfhi(w.z); hb2[2] = hb2[2] * d + bflo(w.w); hb2[3] = hb2[3] * d + bfhi(w.w); } }
}
__device__ __forceinline__ void ssd_finish_item(LAS unsigned char* lds, const bf16_t* cols, const float* ng, bf16_t* Y, const bf16_t* SST, const float* SAC, const bf16_t* CMS, int item) {
    const int tid = tid_o(), wid = tid >> 6, lane = tid & 63, r = lane & 15, q = lane >> 4;
    const int g = item & 1, c = (item >> 1) & 63, b = item >> 7;
    constexpr int MB = 9216;
    LAS unsigned char* CM = lds; LAS unsigned char* HC = lds + MB; LAS float* ACS = (LAS float*)(lds + 5 * MB); LAS float* SSQ = ACS + 256;
    const int prow = tid >> 3, pcol = (tid & 7) * 8;
    lds_barrier();
    *(LAS u32x4*)(CM + (prow * 72 + pcol) * 2) = *(const u32x4*)(CMS + (size_t)item * 4096 + prow * 64 + pcol);
#pragma unroll
    for (int hh = 0; hh < 4; ++hh) *(LAS u32x4*)(HC + hh * MB + (prow * 72 + pcol) * 2) = *(const u32x4*)(SST + ((size_t)(b * 8 + g * 4 + hh) * 64 + c) * 4096 + prow * 64 + pcol);
    if (tid < 256) ACS[tid] = SAC[((size_t)(b * 8 + g * 4 + (tid >> 6)) * 64 + c) * 64 + (tid & 63)];
    lds_barrier();
    const int hh = wid >> 1, half = wid & 1, hd = g * 4 + hh; const size_t tok0 = (size_t)b * SEQ + (size_t)c * 64;
    float yv[2][4][4]; float ssq[2][4];
#pragma unroll
    for (int a = 0; a < 2; ++a) { const int lt = half * 2 + a;
#pragma unroll
        for (int i = 0; i < 4; ++i) ssq[a][i] = 0.f;
#pragma unroll
        for (int pt = 0; pt < 4; ++pt) { f32x4 yo = (f32x4){0.f, 0.f, 0.f, 0.f};
#pragma unroll
            for (int ks = 0; ks < 2; ++ks) yo = MFMA16(lds_frag(CM + ((lt * 16 + r) * 72 + ks * 32 + q * 8) * 2), lds_frag(HC + hh * MB + ((pt * 16 + r) * 72 + ks * 32 + q * 8) * 2), yo);
            const int p = pt * 16 + r;
#pragma unroll
            for (int i = 0; i < 4; ++i) { const int l = lt * 16 + q * 4 + i; const size_t tok = tok0 + l;
                float y = bf2f(Y[tok * 1024 + hd * 64 + p]) + __expf(ACS[hh * 64 + l]) * yo[i];
                y *= silu_f(bf2f(cols[tok * LDC + SSD_Z + hd * 64 + p]));
                yv[a][pt][i] = y; ssq[a][i] += y * y; } }
#pragma unroll
        for (int i = 0; i < 4; ++i) { float s_ = row16_sum(ssq[a][i]);
            if (r == 0) SSQ[(lt * 16 + q * 4 + i) * 4 + hh] = s_; } }
    lds_barrier();
#pragma unroll
    for (int a = 0; a < 2; ++a) { const int lt = half * 2 + a;
#pragma unroll
        for (int i = 0; i < 4; ++i) { const int l = lt * 16 + q * 4 + i; const f32x4 sq = *(const LAS f32x4*)(SSQ + l * 4);
            const float rs = __builtin_amdgcn_rsqf(((sq[0] + sq[1]) + (sq[2] + sq[3])) * (1.f / 256.f) + EPS);
#pragma unroll
            for (int pt = 0; pt < 4; ++pt) { const int p = pt * 16 + r; Y[(tok0 + l) * 1024 + hd * 64 + p] = (bf16_t)f2bf(yv[a][pt][i] * rs * ng[hd * 64 + p]); } } }
}

__device__ __forceinline__ void ssd_fixup(bf16_t* Y, const float* ssdp, const float* ng) {
    const int gt = bid_o() * NT + tid_o(), gn = gridDim.x * NT;
    for (int i = gt; i < T * 64; i += gn) { const int tok = i >> 6, c0 = (i & 63) * 8, g = c0 >> 8;
        const f32x4 pa = *(const f32x4*)(ssdp + (size_t)tok * 16 + g * 8), pb = *(const f32x4*)(ssdp + (size_t)tok * 16 + g * 8 + 4);
        const float s = (pa[0] + pa[1]) + (pa[2] + pa[3]) + (pb[0] + pb[1]) + (pb[2] + pb[3]);
        const float rs = __builtin_amdgcn_rsqf(s * (1.f / 256.f) + EPS);
        bf16_t* yp = Y + (size_t)tok * 1024 + c0; const u32x4 v = *(const u32x4*)yp;
        const f32x4 ga = *(const f32x4*)(ng + c0), gb = *(const f32x4*)(ng + c0 + 4);
        f32x4 a, b2;
        a[0] = bflo(v.x) * rs * ga[0]; a[1] = bfhi(v.x) * rs * ga[1]; a[2] = bflo(v.y) * rs * ga[2]; a[3] = bfhi(v.y) * rs * ga[3];
        b2[0] = bflo(v.z) * rs * gb[0]; b2[1] = bfhi(v.z) * rs * gb[1]; b2[2] = bflo(v.w) * rs * gb[2]; b2[3] = bfhi(v.w) * rs * gb[3];
        *(u32x4*)yp = pg8::pack8(a, b2); }
}
__device__ __forceinline__ void post_rows(const bf16_t* tb, float* h, float cres, const float* gpost, const float* gnext, bf16_t* hb) {
    const int tix = tid_o(); const int lane = tix & 63, gw = bid_o() * (NT / 64) + (tix >> 6), nw = gridDim.x * (NT / 64);
    f32x4 gp[4], gn[4];
#pragma unroll
    for (int j = 0; j < 4; ++j) { gp[j] = *((const f32x4*)gpost + lane + 64 * j); gn[j] = gnext ? *((const f32x4*)gnext + lane + 64 * j) : (f32x4){0.f, 0.f, 0.f, 0.f}; }
    u32x2 tn[4]; f32x4 hn[4];
    if (gw < T) {
#pragma unroll
        for (int j = 0; j < 4; ++j) { tn[j] = *((const u32x2*)(tb + (size_t)gw * D) + lane + 64 * j); hn[j] = *((const f32x4*)(h + (size_t)gw * D) + lane + 64 * j); } }
    for (int row = gw; row < T; row += nw) {
        f32x4 tv[4], hv[4]; float s = 0.f;
#pragma unroll
        for (int j = 0; j < 4; ++j) { tv[j] = (f32x4){bflo(tn[j].x), bfhi(tn[j].x), bflo(tn[j].y), bfhi(tn[j].y)}; hv[j] = hn[j]; }
        if (row + nw < T) {
#pragma unroll
            for (int j = 0; j < 4; ++j) { tn[j] = *((const u32x2*)(tb + (size_t)(row + nw) * D) + lane + 64 * j); hn[j] = *((const f32x4*)(h + (size_t)(row + nw) * D) + lane + 64 * j); } }
#pragma unroll
        for (int j = 0; j < 4; ++j) s += (tv[j][0] * tv[j][0] + tv[j][1] * tv[j][1]) + (tv[j][2] * tv[j][2] + tv[j][3] * tv[j][3]);
        const float rs = __builtin_amdgcn_rsqf(wave_sum(s, lane) * (1.f / D) + EPS) * cres; float s2 = 0.f; f32x4* hp = (f32x4*)(h + (size_t)row * D) + lane;
#pragma unroll
        for (int j = 0; j < 4; ++j) { hv[j] = hv[j] + tv[j] * rs * gp[j]; __builtin_nontemporal_store(hv[j], hp + 64 * j);
            s2 += (hv[j][0] * hv[j][0] + hv[j][1] * hv[j][1]) + (hv[j][2] * hv[j][2] + hv[j][3] * hv[j][3]); }
        if (gnext) { const float r2 = __builtin_amdgcn_rsqf(wave_sum(s2, lane) * (1.f / D) + EPS); u32x2* op = (u32x2*)(hb + (size_t)row * D) + lane;
#pragma unroll
            for (int j = 0; j < 4; ++j) { const f32x4 o = hv[j] * r2 * gn[j]; u32x2 w; w.x = pk2(o[0], o[1]); w.y = pk2(o[2], o[3]); __builtin_nontemporal_store(w, op + 64 * j); } }
    }
}
__device__ __forceinline__ void norm_rows(const float* x, int nrows, const float* g, bf16_t* o, float* cp) {
    const int tix = tid_o(); const int lane = tix & 63, gw = bid_o() * (NT / 64) + (tix >> 6), nw = gridDim.x * (NT / 64);
    for (int row = gw; row < nrows; row += nw) {
        const f32x4* xp = (const f32x4*)(x + (size_t)row * D) + lane; f32x4 v[4]; float s = 0.f;
#pragma unroll
        for (int j = 0; j < 4; ++j) { v[j] = xp[64 * j]; s += (v[j][0] * v[j][0] + v[j][1] * v[j][1]) + (v[j][2] * v[j][2] + v[j][3] * v[j][3]); }
        const float rs = __builtin_amdgcn_rsqf(wave_sum(s, lane) * (1.f / D) + EPS); u32x2* op = (u32x2*)(o + (size_t)row * D) + lane;
#pragma unroll
        for (int j = 0; j < 4; ++j) { const f32x4 gn = *((const f32x4*)g + lane + 64 * j); const f32x4 ov = v[j] * rs * gn; u32x2 w; w.x = pk2(ov[0], ov[1]); w.y = pk2(ov[2], ov[3]); op[64 * j] = w;
            if (cp) ((f32x4*)(cp + (size_t)row * D) + lane)[64 * j] = v[j]; }
    }
}
__device__ __forceinline__ int map_col(int kind, int n, int Nsrc) {
    if (kind == 0) return n < Nsrc ? n : -1;
    if (kind == 1) { const int tile = n >> 8, c = n & 255; return c < 128 ? tile * 128 + c : FF + tile * 128 + (c - 128); }
    if (n >= 384) return -1;
    const int h = n / 96, e = n % 96; if (e < 64) return n;
    const int pos = e - 64, a = pos >> 3, nn = (pos >> 2) & 1, jj = pos & 3; return h * 96 + 64 + nn * 16 + 4 * a + jj;
}
__device__ __forceinline__ void convert_w(LAS unsigned char* lds, const float* W, int K, int Nsrc, int Ndst, bf16_t* Wt, int kind, const float* kscale) {
    LAS float* tile = (LAS float*)lds;
    const int tid = tid_o(), tn = tid & 63, tk = tid >> 6;
    const int nkt = K / 64, nitems = (Ndst / 64) * nkt, G = gridDim.x;
    float v[8];
#define CW_LOAD(IT_) do { const int n0_ = ((IT_) / nkt) * 64, k0_ = ((IT_) % nkt) * 64; const int col = map_col(kind, n0_ + tn, Nsrc); \
        _Pragma("unroll") for (int kk = 0; kk < 8; ++kk) { const int kl = tk + 8 * kk; float x = 0.f; \
            if (col >= 0) { x = W[(size_t)(k0_ + kl) * Nsrc + col]; if (kscale) x *= kscale[k0_ + kl]; } v[kk] = x; } } while (0)
    int it = bid_o();
    __syncthreads();
    if (it < nitems) CW_LOAD(it);
    for (; it < nitems; it += G) { const int n0 = (it / nkt) * 64, k0 = (it % nkt) * 64;
        lds_barrier();
#pragma unroll
        for (int kk = 0; kk < 8; ++kk) tile[tn * 65 + tk + 8 * kk] = v[kk];
        lds_barrier();
        if (it + G < nitems) CW_LOAD(it + G);
        const int row = tid >> 3, ck = (tid & 7) * 8; f32x4 a, b;
#pragma unroll
        for (int j = 0; j < 4; ++j) { a[j] = tile[row * 65 + ck + j]; b[j] = tile[row * 65 + ck + 4 + j]; }
        *(u32x4*)(Wt + (size_t)(n0 + row) * K + k0 + ck) = pg8::pack8(a, b); }
#undef CW_LOAD
    __syncthreads();
}

template <int KC>
__device__ __forceinline__ void row_scales(const bf16_t* A, LAS float* rsl, float sc) {
    const int tid = tid_o(), row = tid >> 1, half = tid & 1; const bf16_t* p = A + (size_t)row * LDC + half * (KC / 2); float s = 0.f;
#pragma unroll
    for (int i = 0; i < KC / 16; ++i) { const u32x4 w = *(const u32x4*)(p + i * 8);
        s += bflo(w.x) * bflo(w.x) + bfhi(w.x) * bfhi(w.x) + bflo(w.y) * bflo(w.y) + bfhi(w.y) * bfhi(w.y) + bflo(w.z) * bflo(w.z) + bfhi(w.z) * bfhi(w.z) + bflo(w.w) * bflo(w.w) + bfhi(w.w) * bfhi(w.w); }
    s += dppf<0xB1>(s);
    if (half == 0) rsl[row] = __builtin_amdgcn_rsqf(s * (1.f / KC) + EPS) * sc;
    __syncthreads();
}
struct Args { const float* in[25]; float* out; unsigned char* ws; };
typedef const unsigned char __attribute__((address_space(4))) kconst_t;
__device__ __forceinline__ kconst_t* karg() { kconst_t* p = (kconst_t*)__builtin_amdgcn_kernarg_segment_ptr(); asm volatile("" : "+s"(p)); return p; }
#define IN(i) (((const float* const __attribute__((address_space(4)))*)karg())[i])
#define OUTP (((float* const __attribute__((address_space(4)))*)karg())[25])
#define WSP(type, off) ((type*)((((unsigned char* const __attribute__((address_space(4)))*)karg())[26]) + (off)))
#define WL(L) (WSP(bf16_t, WS_W) + (size_t)(L) * WL_ELEMS)
__device__ __forceinline__ LayerP layer_p(int L) { LayerP P;
    P.ssd_conv_w = IN(7) + (size_t)L * 4 * 768; P.ssd_conv_b = IN(8) + (size_t)L * 768; P.ssd_dt_bias = IN(9) + L * 8; P.ssd_a_log = IN(10) + L * 8;
    P.ssd_d = IN(11) + L * 8; P.ssd_norm_g = IN(12) + (size_t)L * 512; P.gdn_conv_w = IN(17) + (size_t)L * 4 * 768; P.gdn_dt_bias = IN(18) + L * 4;
    P.gdn_a_log = IN(19) + L * 4; P.gdn_norm_g = IN(20) + L * 64; return P; }

template <int PH>
__device__ __forceinline__ void run_phase(LAS unsigned char* lds, const int L, const int f, const int G) {
    constexpr float LOG2E = 1.4426950408889634f;
    if constexpr (PH == 0) {
        for (int l = 0; l < DEPTH; ++l) { bf16_t* wl = WL(l);
            convert_w(lds, IN(4) + ((size_t)l * 2 + 0) * D * 2 * FF, D, 2 * FF, 2 * FF, wl + W_UP0, 1, nullptr);
            convert_w(lds, IN(4) + ((size_t)l * 2 + 1) * D * 2 * FF, D, 2 * FF, 2 * FF, wl + W_UP1, 1, nullptr);
            convert_w(lds, IN(5) + ((size_t)l * 2 + 0) * FF * D, FF, D, D, wl + W_DN0, 0, nullptr);
            convert_w(lds, IN(5) + ((size_t)l * 2 + 1) * FF * D, FF, D, D, wl + W_DN1, 0, nullptr);
            convert_w(lds, IN(6) + (size_t)l * D * 2736, D, 2736, LDC, wl + W_IN, 0, nullptr);
            convert_w(lds, IN(21) + (size_t)l * D * D, D, D, D, wl + W_OUT, 0, nullptr);
            convert_w(lds, IN(22) + (size_t)l * D * D, D, D, D, wl + W_XQ, 0, nullptr);
            convert_w(lds, IN(23) + (size_t)l * D * 2 * D, D, 2 * D, 2 * D, wl + W_XKV, 0, nullptr);
            convert_w(lds, IN(24) + (size_t)l * D * D, D, D, D, wl + W_XO, 0, nullptr);
            convert_w(lds, IN(14) + (size_t)l * 256 * 384, 256, 384, 512, wl + W_UQ, 2, IN(13) + (size_t)l * 256);
            convert_w(lds, IN(16) + (size_t)l * 128 * 512, 128, 512, 512, wl + W_UKV, 0, IN(15) + (size_t)l * 128);
            norm_rows(IN(1), NB * NMEM, IN(3) + ((size_t)l * 9 + 4) * D, WSP(bf16_t, WS_MEMN) + (size_t)l * 2048 * 1024, nullptr);
        }
        norm_rows(IN(0), T, IN(3), WSP(bf16_t, WS_HB), OUTP);
        const int gt = bid_o() * NT + tid_o(), gn = G * NT; const int* positions = (const int*)IN(2);
        float* cosT = WSP(float, WS_COS); float* sinT = WSP(float, WS_SIN);
        for (int i = gt; i < T * 16; i += gn) { const int tok = i >> 4, fi = i & 15;
            const float inv = 1.0f / powf(10000.0f, (float)(2 * fi) / 32.0f); const float ang = (float)positions[tok] * inv;
            double rev = (double)ang * 0.15915494309189535; rev -= rint(rev); const float rv = (float)rev;
            cosT[i] = __builtin_amdgcn_cosf(rv); sinT[i] = __builtin_amdgcn_sinf(rv); }
        if (gt < 1024) WSP(unsigned, WS_CTL)[gt] = 0u;
        if (gt < 4096) WSP(unsigned, WS_XBAR)[gt] = 0u;
    } else if constexpr (PH == 1) {
        const int bx = bid_o(); const int l = bx >> 6; if (l < DEPTH) { pg8::Gemm g{WSP(bf16_t, WS_MEMN) + (size_t)l * 2048 * 1024, WL(l) + W_XKV, D, D, 2048, 2048, D};
            pg8::StaticOrder S; S.init(2048, 2048, 64, bx & 63); pg8::EpiXaKV E{WSP(bf16_t, WS_XK) + (size_t)l * 2048 * 1024, WSP(bf16_t, WS_XVT) + (size_t)l * 1024 * 2048};
            pg8::gemm_phase(lds, g, S, E); }
    } else if constexpr (PH == 2) {
        pg8::Gemm g{WSP(bf16_t, WS_HB), WL(L) + (f ? W_UP1 : W_UP0), D, D, T, 2 * FF, D}; pg8::StaticOrder S; S.init(T, 2 * FF, G, bid_o()); pg8::EpiSwiGLU E{WSP(bf16_t, WS_BIG)}; pg8::gemm_phase(lds, g, S, E);
    } else if constexpr (PH == 3) {
        pg8::Gemm g{WSP(bf16_t, WS_BIG), WL(L) + (f ? W_DN1 : W_DN0), FF, FF, T, D, FF}; pg8::StaticOrder S; S.init(T, D, G, bid_o()); pg8::EpiBf16S E{WSP(bf16_t, WS_TBUF), D, 1.0f}; pg8::gemm_phase(lds, g, S, E);
    } else if constexpr (PH == 4) {
        const float* ng = IN(3) + (size_t)L * 9 * D;
        if (f == 0) post_rows(WSP(bf16_t, WS_TBUF), OUTP, 0.5f, ng + 1 * D, ng + 2 * D, WSP(bf16_t, WS_HB));
        else post_rows(WSP(bf16_t, WS_TBUF), OUTP, 0.5f, ng + 8 * D, (L + 1 < DEPTH) ? ng + 9 * D : nullptr, WSP(bf16_t, WS_HB));
    } else if constexpr (PH == 5) {
        pg8::Gemm g{WSP(bf16_t, WS_HB), WL(L) + W_IN, D, D, T, LDC, D}; pg8::StaticOrder S; S.init(T, LDC, G, bid_o()); pg8::EpiBf16S E{WSP(bf16_t, WS_BIG), LDC, 1.0f}; pg8::gemm_phase(lds, g, S, E);
    } else if constexpr (PH == 6) {
        { int kq = 256; asm volatile("" : "+s"(kq));
            pg8::Gemm g{WSP(bf16_t, WS_BIG) + MLA_CQ, WL(L) + W_UQ, LDC, 256, T, 512, kq}; pg8::StaticOrder S; S.init(T, 512, G, bid_o());
            pg8::Unit u0; LAS float* rsl = (LAS float*)(lds + 131072);
            if (S.next(0, u0)) row_scales<256>(g.A + (size_t)u0.pm * 256 * LDC, rsl, 0.10206207261596577f * LOG2E);
            pg8::EpiMlaQ E{WSP(bf16_t, WS_MQ), rsl}; pg8::gemm_phase(lds, g, S, E); }
    } else if constexpr (PH == 15) {
        { int kq = 128; asm volatile("" : "+s"(kq));
            pg8::Gemm g{WSP(bf16_t, WS_BIG) + MLA_CKV, WL(L) + W_UKV, LDC, 128, T, 512, kq}; pg8::StaticOrder S; S.init(T, 512, G, bid_o());
            pg8::Unit u0; LAS float* rsl = (LAS float*)(lds + 131072);
            if (S.next(0, u0)) row_scales<128>(g.A + (size_t)u0.pm * 256 * LDC, rsl, 1.0f);
            pg8::EpiMlaKV E{WSP(bf16_t, WS_MK), WSP(bf16_t, WS_MVT), rsl}; pg8::gemm_phase(lds, g, S, E); }
    } else if constexpr (PH == 16) {
        { const int gt = bid_o() * NT + tid_o(), gn = G * NT; const bf16_t* big = WSP(bf16_t, WS_BIG); const float* cosT = WSP(float, WS_COS); const float* sinT = WSP(float, WS_SIN); bf16_t* mk = WSP(bf16_t, WS_MK);
            for (int i = gt; i < T * 16; i += gn) { const int tok = i >> 4, f2 = i & 15;
                const float x1 = bf2f(big[(size_t)tok * LDC + MLA_KR + f2]), x2 = bf2f(big[(size_t)tok * LDC + MLA_KR + 16 + f2]);
                const float c = cosT[i], s = sinT[i]; const bf16_t o1 = (bf16_t)f2bf(x1 * c - x2 * s), o2 = (bf16_t)f2bf(x2 * c + x1 * s);
                const int p1 = 8 * (f2 >> 2) + (f2 & 3); bf16_t* kp = mk + (size_t)tok * 384 + 64 + p1;
#pragma unroll
                for (int hh = 0; hh < 4; ++hh) { kp[hh * 96] = o1; kp[hh * 96 + 4] = o2; } } }
        { const LayerP P = layer_p(L); const bf16_t* big = WSP(bf16_t, WS_BIG); bf16_t* gp = WSP(bf16_t, WS_GP); float* gdec = WSP(float, WS_GDEC);
            for (int it = bid_o(); it < 2048; it += G) gdn_prep_item(lds, big, P, gp, gdec, it);
            for (int it = bid_o(); it < 256; it += G) ssd_prep_range(lds, big, P, WSP(bf16_t, WS_Y), WSP(bf16_t, WS_SST), WSP(float, WS_SAC), WSP(bf16_t, WS_CMS), it >> 5, (it >> 2) & 7, (it & 3) * 16, (it & 3) * 16 + 16); }
    } else if constexpr (PH == 7) {
        volatile LAS int* sh_item = (volatile LAS int*)(lds + MISC_OFF);
        unsigned* done = WSP(unsigned, WS_CTL) + 128 + L * 2 + f;
        for (;;) {
            __syncthreads();
            if (tid_o() == 0) *sh_item = (int)atomicAdd(WSP(unsigned, WS_CTL) + L + 8 * f, 1u);
            __syncthreads();
            const int item = *sh_item;
            if (item >= 32 + 64 + 1024 + 1024) break;
            if (item < 32) { const LayerP P = layer_p(L); gdn_scan_item(lds, WSP(bf16_t, WS_BIG), P, WSP(bf16_t, WS_GP), WSP(float, WS_GDEC), WSP(bf16_t, WS_Y), item); }
            else if (item < 96) { ssd_state_scan_item(lds, WSP(bf16_t, WS_SST), WSP(float, WS_SAC), item - 32);
                __syncthreads();
                if (tid_o() == 0) { __builtin_amdgcn_fence(__ATOMIC_RELEASE, "agent"); __hip_atomic_fetch_add(done, 1u, __ATOMIC_RELAXED, __HIP_MEMORY_SCOPE_AGENT); } }
            else if (item < 96 + 1024) { const int a = item - 96, qb = 31 - (a >> 5), b = (a & 31) >> 2, hh = a & 3; const size_t row0 = (size_t)b * SEQ + qb * 128;
                attn_item<96, 64, 2>(lds, WSP(bf16_t, WS_MQ) + row0 * 512 + hh * 96, 512, WSP(bf16_t, WS_MK) + (size_t)b * SEQ * 384 + hh * 96, 384, WSP(bf16_t, WS_MVT) + (size_t)(b * 256 + hh * 64) * 4096, 4096,
                                     WSP(bf16_t, WS_Y) + row0 * 1024 + 512 + hh * 64, 1024, 2 * qb + 2, 2 * qb + 1, WSP(float, WS_COS) + row0 * 16, WSP(float, WS_SIN) + row0 * 16); }
            else {
                if (tid_o() == 0) { while (__hip_atomic_load(done, __ATOMIC_RELAXED, __HIP_MEMORY_SCOPE_AGENT) < 64u) __builtin_amdgcn_s_sleep(2);
                    __builtin_amdgcn_fence(__ATOMIC_ACQUIRE, "agent"); }
                __syncthreads();
                ssd_finish_item(lds, WSP(bf16_t, WS_BIG), IN(12) + (size_t)L * 512, WSP(bf16_t, WS_Y), WSP(bf16_t, WS_SST), WSP(float, WS_SAC), WSP(bf16_t, WS_CMS), item - (96 + 1024)); }
        }
    } else if constexpr (PH == 8) {
        { const float* ngs = IN(12) + (size_t)L * 512; for (int it = bid_o(); it < 1024; it += G) ssd_finish_item(lds, WSP(bf16_t, WS_BIG), ngs, WSP(bf16_t, WS_Y), WSP(bf16_t, WS_SST), WSP(float, WS_SAC), WSP(bf16_t, WS_CMS), it); }
    } else if constexpr (PH == 9) {
        pg8::Gemm g{WSP(bf16_t, WS_Y), WL(L) + W_OUT, D, D, T, D, D}; pg8::StaticOrder S; S.init(T, D, G, bid_o()); pg8::EpiBf16S E{WSP(bf16_t, WS_TBUF), D, 1.0f}; pg8::gemm_phase(lds, g, S, E);
    } else if constexpr (PH == 10) {
        const float* ng = IN(3) + (size_t)L * 9 * D; post_rows(WSP(bf16_t, WS_TBUF), OUTP, 1.0f, ng + 3 * D, ng + 5 * D, WSP(bf16_t, WS_HB));
    } else if constexpr (PH == 11) {
        pg8::Gemm g{WSP(bf16_t, WS_HB), WL(L) + W_XQ, D, D, T, D, D}; pg8::StaticOrder S; S.init(T, D, G, bid_o()); pg8::EpiBf16S E{WSP(bf16_t, WS_BIG), D, 0.0625f * LOG2E}; pg8::gemm_phase(lds, g, S, E);
    } else if constexpr (PH == 12) {
        for (int it = bid_o(); it < 1024; it += G) { const int qb = it >> 5, b = (it & 31) >> 2, hh = it & 3; const size_t row0 = (size_t)b * SEQ + qb * 128;
            attn_item<256, 256, 2>(lds, WSP(bf16_t, WS_BIG) + row0 * 1024 + hh * 256, 1024, WSP(bf16_t, WS_XK) + (size_t)L * 2048 * 1024 + (size_t)b * 256 * 1024 + hh * 256, 1024,
                                WSP(bf16_t, WS_XVT) + (size_t)L * 1024 * 2048 + (size_t)(hh * 256) * 2048 + b * 256, 2048, WSP(bf16_t, WS_Y) + row0 * 1024 + hh * 256, 1024, 4, 4, nullptr, nullptr); }
    } else if constexpr (PH == 13) {
        pg8::Gemm g{WSP(bf16_t, WS_Y), WL(L) + W_XO, D, D, T, D, D}; pg8::StaticOrder S; S.init(T, D, G, bid_o()); pg8::EpiBf16S E{WSP(bf16_t, WS_TBUF), D, 1.0f}; pg8::gemm_phase(lds, g, S, E);
    } else if constexpr (PH == 14) {
        const float* ng = IN(3) + (size_t)L * 9 * D; post_rows(WSP(bf16_t, WS_TBUF), OUTP, 1.0f, ng + 6 * D, ng + 7 * D, WSP(bf16_t, WS_HB));
    }
}

#ifndef MONO
#define MONO 1
#endif
#define XB_TMO      128
#define XB_XCNT(j)  (256  + 64 * (j))
#define XB_XSUB(j)  (1280 + 64 * (j))
#define XB_XGEN(j)  (2304 + 64 * (j))
#define XB_TOP      3328
#define XB_TOPGEN   3392
#define XCD_BAR_WORDS 3456
#define XB_SPIN_CAP (1u << 18)
__device__ __forceinline__ unsigned xb_ld(unsigned* p)              { return __hip_atomic_load(p, __ATOMIC_RELAXED, __HIP_MEMORY_SCOPE_AGENT); }
__device__ __forceinline__ unsigned xb_add(unsigned* p, unsigned v) { return __hip_atomic_fetch_add(p, v, __ATOMIC_RELAXED, __HIP_MEMORY_SCOPE_AGENT); }
__device__ __forceinline__ unsigned xb_xcc_id() { return (unsigned)__builtin_amdgcn_s_getreg((3 << 11) | 20) & 0xFu; }
#define XB_SPIN(cond, bar) do { unsigned _sp = 0; while (cond) { __builtin_amdgcn_s_sleep(1); \
    if ((++_sp & 255u) == 0u) { if (xb_ld(&(bar)[XB_TMO])) break; if (_sp > XB_SPIN_CAP) { atomicAdd(&(bar)[XB_TMO], 1u); break; } } } } while (0)
__device__ __forceinline__ void xcd_barrier_complete(unsigned* bar, unsigned x, unsigned& nloc, unsigned& nx) {
    const unsigned G = gridDim.x;
    unsigned sum, cnt, mine, sp = 0u;
    for (;;) {
        sum = 0u; cnt = 0u; mine = 0u;
#pragma unroll
        for (unsigned j = 0; j < 16; ++j) { const unsigned c = xb_ld(&bar[XB_XCNT(j)]); sum += c; cnt += (c > 0u) ? 1u : 0u; mine = (j == x) ? c : mine; }
        if (sum == G) break;
        __builtin_amdgcn_s_sleep(1);
        if ((++sp & 255u) == 0u) { if (xb_ld(&bar[XB_TMO])) break; if (sp > XB_SPIN_CAP) { atomicAdd(&bar[XB_TMO], 1u); break; } }
    }
    nloc = mine > 0u ? mine : 1u; nx = cnt > 0u ? cnt : 1u;
}
__device__ __forceinline__ void xcd_barrier(unsigned* bar, volatile LAS unsigned* st) {
    asm volatile("s_waitcnt vmcnt(0)" ::: "memory");
    __syncthreads();
    if (tid_o() == 0) {
        const unsigned x = xb_xcc_id();
        __builtin_amdgcn_s_waitcnt(0);
        unsigned nloc = st[0], nx = st[1];
        if (nloc == 0u) { xcd_barrier_complete(bar, x, nloc, nx); st[0] = nloc; st[1] = nx; }
        const unsigned old = xb_add(&bar[XB_XSUB(x)], 1u);
        const unsigned gen = old / nloc;
        if (old + 1u == (gen + 1u) * nloc) {
            __builtin_amdgcn_fence(__ATOMIC_RELEASE, "agent");
            asm volatile("s_waitcnt vmcnt(0)" ::: "memory");
            const unsigned og = xb_add(&bar[XB_TOP], 1u);
            const unsigned tg = og / nx;
            if (og + 1u == (tg + 1u) * nx) xb_add(&bar[XB_TOPGEN], 1u);
            else XB_SPIN(xb_ld(&bar[XB_TOPGEN]) == tg, bar);
            __builtin_amdgcn_fence(__ATOMIC_ACQUIRE, "agent");
            xb_add(&bar[XB_XGEN(x)], 1u);
            asm volatile("s_waitcnt vmcnt(0)" ::: "memory");
        } else {
            XB_SPIN(xb_ld(&bar[XB_XGEN(x)]) == gen, bar);
            __builtin_amdgcn_fence(__ATOMIC_ACQUIRE, "agent");
            asm volatile("s_waitcnt vmcnt(0)" ::: "memory");
        }
    }
    __syncthreads();
}

#if MONO
#ifndef REP_MASK
#define REP_MASK 0u
#endif
#ifndef CG_SYNC
#define CG_SYNC 0
#endif
__device__ __forceinline__ void gsync(unsigned* ctr, unsigned target) {
    __syncthreads();
    if (tid_o() == 0) {
        __builtin_amdgcn_fence(__ATOMIC_RELEASE, "agent");
        __hip_atomic_fetch_add(ctr, 1u, __ATOMIC_RELAXED, __HIP_MEMORY_SCOPE_AGENT);
        while (__hip_atomic_load(ctr, __ATOMIC_RELAXED, __HIP_MEMORY_SCOPE_AGENT) < target) __builtin_amdgcn_s_sleep(1);
        __builtin_amdgcn_fence(__ATOMIC_ACQUIRE, "agent");
    }
    __syncthreads();
}
__global__ void __launch_bounds__(NT, 2) fwd_kernel(Args args) {
    extern __shared__ __attribute__((aligned(16))) unsigned char lds_raw[];
    LAS unsigned char* lds = (LAS unsigned char*)lds_raw;
    cg::grid_group grid = cg::this_grid();
    const int G = gridDim.x;
    unsigned nb = 0;
    if ((threadIdx.x & 63) == 0) *(volatile LAS int*)(unsigned)(MISC_OFF + 64 + hw_slot() * 4) = (int)(threadIdx.x >> 6);
    if (threadIdx.x < 2) *(volatile LAS unsigned*)(unsigned)(MISC_OFF + 8 + threadIdx.x * 4) = 0u;
    __syncthreads();
#if CG_SYNC
#define GSYNC() grid.sync()
#else
#define GSYNC() xcd_barrier(WSP(unsigned, WS_XBAR), (volatile LAS unsigned*)(lds + MISC_OFF + 8))
#endif
#define RUN(P, L, f) do { run_phase<P>(lds, L, f, G); if ((REP_MASK >> P) & 1u) { GSYNC(); run_phase<P>(lds, L, (P == 7) ? 1 : f, G); } } while (0)
    run_phase<0>(lds, 0, 0, G); grid.sync();
    if (tid_o() == 0) (void)xb_add(WSP(unsigned, WS_XBAR) + XB_XCNT(xb_xcc_id()), 1u);
    run_phase<1>(lds, 0, 0, G); GSYNC();
#define LAYER(L) \
        RUN(2, L, 0); GSYNC(); RUN(3, L, 0); GSYNC(); run_phase<4>(lds, L, 0, G); GSYNC(); \
        RUN(5, L, 0); GSYNC(); RUN(6, L, 0); __syncthreads(); RUN(15, L, 0); __syncthreads(); RUN(16, L, 0); GSYNC(); RUN(7, L, 0); GSYNC(); \
        RUN(9, L, 0); GSYNC(); run_phase<10>(lds, L, 0, G); GSYNC(); \
        RUN(11, L, 0); GSYNC(); RUN(12, L, 0); GSYNC(); RUN(13, L, 0); GSYNC(); run_phase<14>(lds, L, 0, G); GSYNC(); \
        RUN(2, L, 1); GSYNC(); RUN(3, L, 1); GSYNC(); run_phase<4>(lds, L, 1, G); GSYNC();
    LAYER(0) LAYER(1) LAYER(2) LAYER(3)
#undef LAYER
#undef RUN
#undef GSYNC
}
#else
template <int PH>
__global__ void __launch_bounds__(NT, 2) phase_kernel(Args args, int L, int f) {
    extern __shared__ __attribute__((aligned(16))) unsigned char lds_raw[];
    if ((threadIdx.x & 63) == 0) *(volatile LAS int*)(unsigned)(MISC_OFF + 64 + hw_slot() * 4) = (int)(threadIdx.x >> 6);
    __syncthreads();
    run_phase<PH>((LAS unsigned char*)lds_raw, L, f, gridDim.x);
}
#endif

#if !MONO
#ifndef PH_MASK
#define PH_MASK 0x1FFFFu
#endif
template <int PH> static void launch_phase(const Args& a, int L, int f, int grid, hipStream_t stream) {
    if (!((PH_MASK >> PH) & 1u)) return;
    static bool attr = false;
    if (!attr) { (void)hipFuncSetAttribute((const void*)phase_kernel<PH>, hipFuncAttributeMaxDynamicSharedMemorySize, LDS_BYTES); attr = true; }
    hipLaunchKernelGGL(phase_kernel<PH>, dim3(grid), dim3(NT), LDS_BYTES, stream, a, L, f);
}
#endif
extern "C" void kernel_launch(void* const* d_in, const int* in_sizes, int n_in, void* d_out, int out_size, void* d_ws, size_t ws_size, hipStream_t stream) {
    static int grid = 0;
    if (grid == 0) {
        if (n_in != 25 || out_size != T * D || ws_size < WS_END) { fprintf(stderr, "kernel_launch: unexpected shapes (n_in %d out %d ws %zu need %zu)\n", n_in, out_size, ws_size, (size_t)WS_END); grid = -1; return; }
        int dev = 0, cus = 0;
        (void)hipGetDevice(&dev); (void)hipDeviceGetAttribute(&cus, hipDeviceAttributeMultiprocessorCount, dev);
#if MONO
        int per_cu = 0;
        if (hipFuncSetAttribute((const void*)fwd_kernel, hipFuncAttributeMaxDynamicSharedMemorySize, LDS_BYTES) != hipSuccess) { fprintf(stderr, "kernel_launch: hipFuncSetAttribute failed\n"); grid = -1; return; }
        if (hipOccupancyMaxActiveBlocksPerMultiprocessor(&per_cu, (const void*)fwd_kernel, NT, LDS_BYTES) != hipSuccess || per_cu < 1) fprintf(stderr, "kernel_launch: occupancy query gave %d\n", per_cu);
        (void)hipGetLastError();
#endif
        grid = cus;
        if (cus != 256) { fprintf(stderr, "kernel_launch: built for 256 CUs, got %d\n", cus); grid = -1; return; }
    }
    if (grid < 0) return;
    Args a{};
    for (int i = 0; i < 25; ++i) a.in[i] = (const float*)d_in[i];
    a.out = (float*)d_out; a.ws = (unsigned char*)d_ws;
#if MONO
    void* kargs[] = {&a};
    hipError_t e = hipLaunchCooperativeKernel((const void*)fwd_kernel, dim3(grid), dim3(NT), kargs, LDS_BYTES, stream);
    if (e != hipSuccess) fprintf(stderr, "cooperative launch failed: %s (grid %d)\n", hipGetErrorString(e), grid);
#else
    launch_phase<0>(a, 0, 0, grid, stream); launch_phase<1>(a, 0, 0, grid, stream);
    for (int L = 0; L < DEPTH; ++L) {
        launch_phase<2>(a, L, 0, grid, stream); launch_phase<3>(a, L, 0, grid, stream); launch_phase<4>(a, L, 0, grid, stream);
        launch_phase<5>(a, L, 0, grid, stream); launch_phase<6>(a, L, 0, grid, stream); launch_phase<15>(a, L, 0, grid, stream); launch_phase<16>(a, L, 0, grid, stream); launch_phase<7>(a, L, 0, grid, stream);
        launch_phase<9>(a, L, 0, grid, stream); launch_phase<10>(a, L, 0, grid, stream);
        launch_phase<11>(a, L, 0, grid, stream); launch_phase<12>(a, L, 0, grid, stream); launch_phase<13>(a, L, 0, grid, stream); launch_phase<14>(a, L, 0, grid, stream);
        launch_phase<2>(a, L, 1, grid, stream); launch_phase<3>(a, L, 1, grid, stream); launch_phase<4>(a, L, 1, grid, stream);
    }
#endif
}
```

```cpp
#include <hip/hip_runtime.h>
#include <hip/hip_cooperative_groups.h>
#include <cstdio>
#include <cstdint>
namespace cg = cooperative_groups;

#define LAS __attribute__((address_space(3)))
typedef unsigned short bf16_t;
typedef short bf16x8 __attribute__((ext_vector_type(8)));
typedef float f32x4 __attribute__((ext_vector_type(4)));
typedef unsigned u32x4 __attribute__((ext_vector_type(4)));
typedef unsigned u32x2 __attribute__((ext_vector_type(2)));

constexpr int NB = 8, SEQ = 4096, T = NB * SEQ, D = 1024, FF = 2816, DEPTH = 4, NMEM = 256;
constexpr int LDC = 2816;
constexpr int SSD_Z = 0, SSD_XBC = 512, SSD_DT = 1280;
constexpr int MLA_CQ = 1288, MLA_CKV = 1544, MLA_KR = 1672;
constexpr int GDN_QKV = 1704, GDN_Z = 2472, GDN_B = 2728, GDN_A = 2732;
constexpr float EPS = 1e-6f;
constexpr int NT = 512;
constexpr int LDS_BYTES = 143360;
constexpr int MISC_OFF = 142848;

constexpr size_t W_UP0 = 0, W_UP1 = 5767168, W_DN0 = 11534336, W_DN1 = 14417920, W_IN = 17301504, W_OUT = 20185088,
                 W_XQ = 21233664, W_XKV = 22282240, W_XO = 24379392, W_UQ = 25427968, W_UKV = 25559040, WL_ELEMS = 25624576;

constexpr size_t WS_CTL = 0;
constexpr size_t WS_COS = 4096;
constexpr size_t WS_SIN = WS_COS + (size_t)T * 16 * 4;
constexpr size_t WS_SSQQ = WS_SIN + (size_t)T * 16 * 4;
constexpr size_t WS_SSQKV = WS_SSQQ + (size_t)T * 4;
constexpr size_t WS_SSDP = WS_SSQKV + (size_t)T * 4;
constexpr size_t WS_GDEC = WS_SSDP + (size_t)T * 16 * 4;
constexpr size_t WS_MEMN = WS_GDEC + 8192;
constexpr size_t WS_XK = WS_MEMN + (size_t)4 * 2048 * 1024 * 2;
constexpr size_t WS_XVT = WS_XK + (size_t)4 * 2048 * 1024 * 2;
constexpr size_t WS_W = WS_XVT + (size_t)4 * 2048 * 1024 * 2;
constexpr size_t WS_TBUF = WS_W + (size_t)DEPTH * WL_ELEMS * 2;
constexpr size_t WS_HB = WS_TBUF + (size_t)T * 1024 * 4;
constexpr size_t WS_BIG = WS_HB + (size_t)T * 1024 * 2;
constexpr size_t WS_Y = WS_BIG + (size_t)T * 2816 * 2;
constexpr size_t WS_CMS = WS_Y + (size_t)T * 1024 * 2;
constexpr size_t WS_SAC = WS_CMS + (size_t)1024 * 4096 * 2;
constexpr size_t WS_XBAR = WS_SAC + (size_t)4096 * 64 * 4;
constexpr size_t WS_END = WS_XBAR + 16384;
constexpr size_t WS_MQ = WS_TBUF;
constexpr size_t WS_MK = WS_MQ + (size_t)T * 512 * 2;
constexpr size_t WS_MVT = WS_MK + (size_t)T * 384 * 2;
constexpr size_t WS_GP = WS_MVT + (size_t)8 * 256 * 4096 * 2;
constexpr size_t WS_SST = WS_GP + (size_t)2048 * 5 * 4096 * 2;
constexpr size_t WS_MIXEND = WS_SST + (size_t)4096 * 4096 * 2;
static_assert(WS_MIXEND <= WS_BIG, "mixer scratch must fit in TBUF+HB");

typedef float f32x2_t __attribute__((ext_vector_type(2)));
typedef __bf16 bf16x2_t __attribute__((ext_vector_type(2)));
__device__ __forceinline__ unsigned pk2(float lo, float hi) { const f32x2_t v = {lo, hi}; const bf16x2_t b = __builtin_convertvector(v, bf16x2_t); return __builtin_bit_cast(unsigned, b); }
__device__ __forceinline__ unsigned f2bf(float f) { return pk2(f, f) & 0xffffu; }
__device__ __forceinline__ float bf2f(unsigned b) { return __builtin_bit_cast(float, (b & 0xffffu) << 16); }
__device__ __forceinline__ float bflo(unsigned w) { return __builtin_bit_cast(float, w << 16); }
__device__ __forceinline__ float bfhi(unsigned w) { return __builtin_bit_cast(float, w & 0xffff0000u); }
__device__ __forceinline__ float silu_f(float x) { return x * __builtin_amdgcn_rcpf(1.f + __expf(-x)); }
__device__ __forceinline__ float softplus_f(float x) { return x > 20.f ? x : __logf(1.f + __expf(x)); }
__device__ __forceinline__ unsigned hw_slot() { return (unsigned)__builtin_amdgcn_s_getreg((5 << 11) | 4) & 63u; }
__device__ __forceinline__ int tid_o() {
    const int wv = __builtin_amdgcn_readfirstlane(*(volatile LAS int*)(unsigned)(MISC_OFF + 64 + hw_slot() * 4));
    int ln; asm volatile("v_mbcnt_lo_u32_b32 %0, -1, 0\n\tv_mbcnt_hi_u32_b32 %0, -1, %0" : "=v"(ln));
    return wv * 64 + ln; }
__device__ __forceinline__ int bid_o() { int b = blockIdx.x; asm volatile("" : "+s"(b)); return b; }
#define MFMA16(a, b, c) __builtin_amdgcn_mfma_f32_16x16x32_bf16(a, b, c, 0, 0, 0)

namespace pg8 {
constexpr int BM = 256, BK = 64, HALF = 128, HTB = HALF * BK * 2, STAGE_BYTES = 8 * HTB, NXCD = 8, WGM = 8;
__device__ __forceinline__ int lds_byte(int r, int c) { const int st = (r >> 4) * 2 + (c >> 5), rr = r & 15, cc = c & 31, ob = rr * 64 + cc * 2; return st * 1024 + (ob ^ (((ob >> 9) & 1) << 5)); }
__device__ __forceinline__ void stage_rc(int b, int& R, int& C) { const int st = b / 1024, sb = b % 1024, swz = sb ^ (((sb >> 9) & 1) << 5); R = (st >> 1) * 16 + swz / 64; C = (st & 1) * 32 + (swz % 64) / 2; }
__device__ __forceinline__ int perm32(int rho) { const int n = rho >> 4, i = rho & 15; return 8 * (i >> 2) + 4 * n + (i & 3); }
struct Unit { int pm, pn; };
struct Gemm { const bf16_t* A; const bf16_t* Bt; int lda, ldb, M, N, K; };
struct StaticOrder {
    int nM, nN, nwg, G, c;
    __device__ void init(int M, int N, int G_, int c_) { nM = M / BM; nN = N / BM; nwg = nM * nN; G = G_; c = c_; }
    __device__ bool next(int i, Unit& u) const {
        const long L = (long)i * G + c; if (L >= nwg) return false;
        int wgid = (int)L; { const int q = nwg / NXCD, r = nwg % NXCD, xcd = wgid % NXCD, off = wgid / NXCD; wgid = (xcd < r ? xcd * (q + 1) : r * (q + 1) + (xcd - r) * q) + off; }
        const int nig = WGM * nN, gid = wgid / nig, fm = gid * WGM, gsz = (nM - fm) < WGM ? (nM - fm) : WGM;
        u.pm = fm + ((wgid % nig) % gsz); u.pn = (wgid % nig) / gsz; return true;
    }
};
template <class Epi>
__device__ __forceinline__ void gemm_phase(LAS unsigned char* lds, const Gemm g, const StaticOrder& S, const Epi& E) {
    const int tid = tid_o(), wid = __builtin_amdgcn_readfirstlane(tid >> 6), lane = tid & 63, wr = wid >> 2, wc = wid & 3, fr = lane & 15, fq = lane >> 4;
    const int K = g.K, nt = K / BK;
    unsigned voffA[2], voffB[2];
#pragma unroll
    for (int i = 0; i < 2; ++i) { int R, C; stage_rc(tid * 16 + i * 8192, R, C); const int Rb = (R & ~31) + perm32(R & 31);
        voffA[i] = (unsigned)(R * g.lda + C) * 2u; voffB[i] = (unsigned)(Rb * g.ldb + C) * 2u; }
    const size_t kstep = (size_t)(BK * 2);
    const size_t hA = (size_t)HALF * g.lda * 2, hB = (size_t)HALF * g.ldb * 2;
    const size_t tA = 2 * hA, tB = 2 * hB;
    const unsigned ldsw = (unsigned)wid * 1024u;
    const int aoff = lds_byte(wr * 64 + fr, fq * 8), boff = lds_byte(wc * 32 + fr, fq * 8);
#define PG8_SA(b, h) (((b) * 2 + (h)) * HTB)
#define PG8_SB(b, h) ((4 + (b) * 2 + (h)) * HTB)
#define PG8_STAGE(bufoff, gbase, voff) do { _Pragma("unroll") for (int _i = 0; _i < 2; ++_i) \
        __builtin_amdgcn_global_load_lds((const unsigned*)((const char*)(gbase) + (voff)[_i]), (LAS unsigned*)(lds + (bufoff) + ldsw + _i * 8192), 16, 0, 0); } while (0)
#define PG8_LDA(dst, b, h) do { _Pragma("unroll") for (int m = 0; m < 4; ++m) _Pragma("unroll") for (int k = 0; k < 2; ++k) dst[m][k] = *(const LAS bf16x8*)(lds + PG8_SA(b, h) + aoff + m * 2048 + k * 1024); } while (0)
#define PG8_LDB(dst, b, h) do { _Pragma("unroll") for (int n = 0; n < 2; ++n) _Pragma("unroll") for (int k = 0; k < 2; ++k) dst[n][k] = *(const LAS bf16x8*)(lds + PG8_SB(b, h) + boff + n * 2048 + k * 1024); } while (0)
#define PG8_MMA(ai, bj, At, Bt) do { __builtin_amdgcn_s_setprio(1); _Pragma("unroll") for (int m = 0; m < 4; ++m) _Pragma("unroll") for (int n = 0; n < 2; ++n) _Pragma("unroll") for (int k = 0; k < 2; ++k) \
        acc[ai][bj][m][n] = __builtin_amdgcn_mfma_f32_16x16x32_bf16(Bt[n][k], At[m][k], acc[ai][bj][m][n], 0, 0, 0); __builtin_amdgcn_s_setprio(0); } while (0)
#define PG8_WAIT_V(n) asm volatile("s_waitcnt vmcnt(" #n ")" ::: "memory")
#define PG8_WAIT_L(n) asm volatile("s_waitcnt lgkmcnt(" #n ")" ::: "memory")
#define PG8_BAR __builtin_amdgcn_s_barrier()
#define PG8_SCHED __builtin_amdgcn_sched_barrier(0)
    Unit cur, nxt; int ui = 0;
    if (!S.next(0, cur)) return;
    f32x4 acc[2][2][4][2];
#pragma unroll
    for (int a = 0; a < 2; ++a)
#pragma unroll
        for (int b = 0; b < 2; ++b)
#pragma unroll
            for (int m = 0; m < 4; ++m)
#pragma unroll
                for (int n = 0; n < 2; ++n) acc[a][b][m][n] = (f32x4){0.f, 0.f, 0.f, 0.f};
    bf16x8 At[4][2], B0[2][2], B1[2][2];
    const char* cA = (const char*)g.A + (size_t)cur.pm * tA; const char* cB = (const char*)g.Bt + (size_t)cur.pn * tB;
    PG8_STAGE(PG8_SB(0, 0), cB, voffB); PG8_STAGE(PG8_SB(0, 1), cB + hB, voffB); PG8_STAGE(PG8_SA(0, 0), cA, voffA); PG8_STAGE(PG8_SA(0, 1), cA + hA, voffA);
    if (wr == 1) PG8_BAR;
    PG8_WAIT_V(2); PG8_BAR;
    PG8_STAGE(PG8_SB(1, 0), cB + kstep, voffB); PG8_STAGE(PG8_SA(1, 0), cA + kstep, voffA); PG8_STAGE(PG8_SB(1, 1), cB + hB + kstep, voffB);
    PG8_WAIT_V(6); PG8_BAR;
    for (;;) {
        const bool has_next = S.next(ui + 1, nxt);
        const char* nA = has_next ? (const char*)g.A + (size_t)nxt.pm * tA : cA; const char* nB = has_next ? (const char*)g.Bt + (size_t)nxt.pn * tB : cB;
        for (int t = 0; t < nt; t += 2) {
            const bool last = (t == nt - 2);
            const char* a1 = cA + (size_t)(t + 1) * kstep;
            const char* a2 = last ? nA : cA + (size_t)(t + 2) * kstep; const char* b2 = last ? nB : cB + (size_t)(t + 2) * kstep;
            const char* a3 = a2 + kstep; const char* b3 = b2 + kstep;
            PG8_LDB(B0, 0, 0); PG8_LDB(B1, 0, 1); PG8_SCHED; PG8_LDA(At, 0, 0); PG8_STAGE(PG8_SA(1, 1), a1 + hA, voffA);
            PG8_WAIT_V(8); PG8_WAIT_L(0); PG8_BAR; PG8_MMA(0, 0, At, B0); PG8_MMA(0, 1, At, B1); PG8_BAR; PG8_SCHED;
            PG8_LDA(At, 0, 1); PG8_STAGE(PG8_SB(0, 0), b2, voffB); PG8_STAGE(PG8_SB(0, 1), b2 + hB, voffB); PG8_STAGE(PG8_SA(0, 0), a2, voffA);
            PG8_WAIT_V(8); PG8_WAIT_L(0); PG8_BAR; PG8_MMA(1, 0, At, B0); PG8_MMA(1, 1, At, B1); PG8_BAR; PG8_SCHED;
            PG8_LDB(B0, 1, 0); PG8_LDB(B1, 1, 1); PG8_SCHED; PG8_LDA(At, 1, 0); PG8_STAGE(PG8_SA(0, 1), a2 + hA, voffA);
            PG8_WAIT_V(8); PG8_WAIT_L(0); PG8_BAR; PG8_MMA(0, 0, At, B0); PG8_MMA(0, 1, At, B1); PG8_BAR; PG8_SCHED;
            PG8_LDA(At, 1, 1); PG8_STAGE(PG8_SB(1, 0), b3, voffB); PG8_STAGE(PG8_SB(1, 1), b3 + hB, voffB); PG8_STAGE(PG8_SA(1, 0), a3, voffA);
            PG8_WAIT_V(8); PG8_WAIT_L(0); PG8_BAR; PG8_MMA(1, 0, At, B0); PG8_MMA(1, 1, At, B1); PG8_BAR; PG8_SCHED;
        }
        if (wr == 0) PG8_BAR;
        { int fr_e = fr, fq_e = fq; asm volatile("" : "+v"(fr_e), "+v"(fq_e)); E(acc, cur, wr, wc, fr_e, fq_e); }
        if (!has_next) break;
#pragma unroll
        for (int a = 0; a < 2; ++a)
#pragma unroll
            for (int b = 0; b < 2; ++b)
#pragma unroll
                for (int m = 0; m < 4; ++m)
#pragma unroll
                    for (int n = 0; n < 2; ++n) acc[a][b][m][n] = (f32x4){0.f, 0.f, 0.f, 0.f};
        cur = nxt; cA = nA; cB = nB; ++ui;
        if (wr == 1) PG8_BAR;
    }
    PG8_WAIT_V(0);
    PG8_BAR;
#undef PG8_SA
#undef PG8_SB
#undef PG8_STAGE
#undef PG8_LDA
#undef PG8_LDB
#undef PG8_MMA
#undef PG8_WAIT_V
#undef PG8_WAIT_L
#undef PG8_BAR
#undef PG8_SCHED
}
typedef const f32x4 (&AccRef)[2][2][4][2];
__device__ __forceinline__ u32x4 pack8(f32x4 a, f32x4 b) { u32x4 w; w.x = pk2(a[0], a[1]); w.y = pk2(a[2], a[3]); w.z = pk2(b[0], b[1]); w.w = pk2(b[2], b[3]); return w; }

struct EpiSwiGLU { bf16_t* O;
    __device__ __forceinline__ void operator()(AccRef acc, const Unit& u, int wr, int wc, int fr, int fq) const {
        const int row0 = u.pm * BM + wr * 64 + fr, col0 = u.pn * 128 + wc * 32 + fq * 8;
#pragma unroll
        for (int ai = 0; ai < 2; ++ai)
#pragma unroll
            for (int m = 0; m < 4; ++m) { const int row = row0 + ai * HALF + m * 16; f32x4 v0, v1;
#pragma unroll
                for (int j = 0; j < 4; ++j) { v0[j] = silu_f(acc[ai][0][m][0][j]) * acc[ai][1][m][0][j]; v1[j] = silu_f(acc[ai][0][m][1][j]) * acc[ai][1][m][1][j]; }
                *(u32x4*)(O + (size_t)row * FF + col0) = pack8(v0, v1); }
    }
};
struct EpiF32 { float* O; int ldc;
    __device__ __forceinline__ void operator()(AccRef acc, const Unit& u, int wr, int wc, int fr, int fq) const {
        const int row0 = u.pm * BM + wr * 64 + fr, col0 = u.pn * BM + wc * 32 + fq * 8;
#pragma unroll
        for (int ai = 0; ai < 2; ++ai)
#pragma unroll
            for (int m = 0; m < 4; ++m) { float* rp = O + (size_t)(row0 + ai * HALF + m * 16) * ldc + col0;
#pragma unroll
                for (int bj = 0; bj < 2; ++bj) { *(f32x4*)(rp + bj * HALF) = acc[ai][bj][m][0]; *(f32x4*)(rp + bj * HALF + 4) = acc[ai][bj][m][1]; } }
    }
};
struct EpiBf16S { bf16_t* O; int ldc; float sc;
    __device__ __forceinline__ void operator()(AccRef acc, const Unit& u, int wr, int wc, int fr, int fq) const {
        const int row0 = u.pm * BM + wr * 64 + fr, col0 = u.pn * BM + wc * 32 + fq * 8;
#pragma unroll
        for (int ai = 0; ai < 2; ++ai)
#pragma unroll
            for (int m = 0; m < 4; ++m) { bf16_t* rp = O + (size_t)(row0 + ai * HALF + m * 16) * ldc + col0;
#pragma unroll
                for (int bj = 0; bj < 2; ++bj) *(u32x4*)(rp + bj * HALF) = pack8(acc[ai][bj][m][0] * sc, acc[ai][bj][m][1] * sc); }
    }
};
struct EpiCols { bf16_t* O; float* ssqq; float* ssqkv;
    __device__ __forceinline__ void operator()(AccRef acc, const Unit& u, int wr, int wc, int fr, int fq) const {
        const int row0 = u.pm * BM + wr * 64 + fr, col0 = u.pn * BM + wc * 32 + fq * 8;
#pragma unroll
        for (int ai = 0; ai < 2; ++ai)
#pragma unroll
            for (int m = 0; m < 4; ++m) { const int row = row0 + ai * HALF + m * 16; bf16_t* rp = O + (size_t)row * LDC + col0;
#pragma unroll
                for (int bj = 0; bj < 2; ++bj) { const f32x4 v0 = acc[ai][bj][m][0], v1 = acc[ai][bj][m][1];
                    *(u32x4*)(rp + bj * HALF) = pack8(v0, v1);
                    const int c = col0 + bj * HALF;
                    if (c >= MLA_CQ && c < MLA_KR) { float s = 0.f;
#pragma unroll
                        for (int j = 0; j < 4; ++j) s += v0[j] * v0[j] + v1[j] * v1[j];
                        __hip_atomic_fetch_add((c < MLA_CKV ? ssqq : ssqkv) + row, s, __ATOMIC_RELAXED, __HIP_MEMORY_SCOPE_AGENT); } } }
    }
};
struct EpiMlaQ { bf16_t* O; const LAS float* rsl;
    __device__ __forceinline__ void operator()(AccRef acc, const Unit& u, int wr, int wc, int fr, int fq) const {
        const int row0 = u.pm * BM + wr * 64 + fr, col0 = u.pn * BM + wc * 32 + fq * 8;
#pragma unroll
        for (int ai = 0; ai < 2; ++ai)
#pragma unroll
            for (int m = 0; m < 4; ++m) { const int row = row0 + ai * HALF + m * 16; const float rs = rsl[wr * 64 + fr + ai * HALF + m * 16]; bf16_t* rp = O + (size_t)row * 512 + col0;
#pragma unroll
                for (int bj = 0; bj < 2; ++bj) *(u32x4*)(rp + bj * HALF) = pack8(acc[ai][bj][m][0] * rs, acc[ai][bj][m][1] * rs); }
    }
};
struct EpiMlaKV { bf16_t* Kb; bf16_t* VT; const LAS float* rsl;
    __device__ __forceinline__ void operator()(AccRef acc, const Unit& u, int wr, int wc, int fr, int fq) const {
        const int row0 = u.pm * BM + wr * 64 + fr;
#pragma unroll
        for (int ai = 0; ai < 2; ++ai)
#pragma unroll
            for (int m = 0; m < 4; ++m) { const int row = row0 + ai * HALF + m * 16; const float rs = rsl[wr * 64 + fr + ai * HALF + m * 16];
                const int b = row >> 12, s = row & 4095;
#pragma unroll
                for (int bj = 0; bj < 2; ++bj) { const int cb = u.pn * BM + bj * HALF + wc * 32; const int h = cb >> 7, e0 = cb & 127;
                    const f32x4 v0 = acc[ai][bj][m][0] * rs, v1 = acc[ai][bj][m][1] * rs;
                    if (e0 < 64) *(u32x4*)(Kb + (size_t)row * 384 + h * 96 + e0 + fq * 8) = pack8(v0, v1);
                    else { bf16_t* vp = VT + ((size_t)(b * 256 + h * 64 + e0 - 64 + fq * 8) * 4096) + s;
#pragma unroll
                        for (int j = 0; j < 4; ++j) { vp[(size_t)j * 4096] = (bf16_t)f2bf(v0[j]); vp[(size_t)(4 + j) * 4096] = (bf16_t)f2bf(v1[j]); } } } }
    }
};
struct EpiXaKV { bf16_t* Kb; bf16_t* VT;
    __device__ __forceinline__ void operator()(AccRef acc, const Unit& u, int wr, int wc, int fr, int fq) const {
        const int row0 = u.pm * BM + wr * 64 + fr, col0 = u.pn * BM + wc * 32 + fq * 8;
#pragma unroll
        for (int ai = 0; ai < 2; ++ai)
#pragma unroll
            for (int m = 0; m < 4; ++m) { const int row = row0 + ai * HALF + m * 16;
#pragma unroll
                for (int bj = 0; bj < 2; ++bj) { const int c = col0 + bj * HALF; const f32x4 v0 = acc[ai][bj][m][0], v1 = acc[ai][bj][m][1];
                    if (c < 1024) *(u32x4*)(Kb + (size_t)row * 1024 + c) = pack8(v0, v1);
                    else { bf16_t* vp = VT + (size_t)(c - 1024) * 2048 + row;
#pragma unroll
                        for (int j = 0; j < 4; ++j) { vp[(size_t)j * 2048] = (bf16_t)f2bf(v0[j]); vp[(size_t)(4 + j) * 2048] = (bf16_t)f2bf(v1[j]); } } } }
    }
};
}

__device__ __forceinline__ void lds_barrier() { asm volatile("s_waitcnt lgkmcnt(0)" ::: "memory"); __builtin_amdgcn_s_barrier(); asm volatile("" ::: "memory"); }
template <int CTRL> __device__ __forceinline__ float dppf(float v) { return __builtin_bit_cast(float, __builtin_amdgcn_update_dpp(0, __builtin_bit_cast(int, v), CTRL, 0xF, 0xF, true)); }
__device__ __forceinline__ float row16_max(float v) { v = fmaxf(v, dppf<0xB1>(v)); v = fmaxf(v, dppf<0x4E>(v)); v = fmaxf(v, dppf<0x141>(v)); v = fmaxf(v, dppf<0x140>(v)); return v; }
__device__ __forceinline__ float row16_sum(float v) { v += dppf<0xB1>(v); v += dppf<0x4E>(v); v += dppf<0x141>(v); v += dppf<0x140>(v); return v; }
__device__ __forceinline__ float bperm_f(float v, int srclane) { return __builtin_bit_cast(float, __builtin_amdgcn_ds_bpermute(srclane << 2, __builtin_bit_cast(int, v))); }
__device__ __forceinline__ float wave_sum(float v, int lane) { v = row16_sum(v); v += bperm_f(v, lane ^ 16); v += bperm_f(v, lane ^ 32); return v; }
__device__ __forceinline__ float row8_sum(float v) { v += dppf<0xB1>(v); v += dppf<0x4E>(v); v += dppf<0x141>(v); return v; }
__device__ __forceinline__ bf16x8 lds_frag(const LAS unsigned char* p) { return *(const LAS bf16x8*)p; }

template <int DQK, int DV, int NST>
__device__ __forceinline__ void attn_item(LAS unsigned char* lds, const bf16_t* Q, int ldq, const bf16_t* Kp, int ldk, const bf16_t* VT, int ldv,
                                          bf16_t* Y, int ldy, int nkt, int nkt_lo, const float* cs, const float* sn) {
    constexpr int KS = DQK / 32, KST = DQK + 8, NVT = DV / 16;
    constexpr int KT_BYTES = 64 * KST * 2, VT_BYTES = DV * 72 * 2, ST_BYTES = KT_BYTES + VT_BYTES;
    constexpr int KPC = 64 * DQK / 8, VPC = DV * 8;
    constexpr int KPT = (KPC + NT - 1) / NT, VPT = (VPC + NT - 1) / NT;
    static_assert(NST * ST_BYTES <= MISC_OFF, "attention LDS");
    const int tid = tid_o(), wid = tid >> 6, lane = tid & 63, r = lane & 15, q = lane >> 4;
    bf16x8 qf[KS];
#pragma unroll
    for (int ks = 0; ks < KS; ++ks) qf[ks] = *(const bf16x8*)(Q + (size_t)(wid * 16 + r) * ldq + ks * 32 + q * 8);
    if constexpr (DQK == 96) {
        const f32x4 c4 = *(const f32x4*)(cs + (size_t)(wid * 16 + r) * 16 + q * 4), s4 = *(const f32x4*)(sn + (size_t)(wid * 16 + r) * 16 + q * 4);
        const u32x4 w = __builtin_bit_cast(u32x4, qf[2]);
        const f32x4 x1 = {bflo(w.x), bfhi(w.x), bflo(w.y), bfhi(w.y)}, x2 = {bflo(w.z), bfhi(w.z), bflo(w.w), bfhi(w.w)};
        qf[2] = __builtin_bit_cast(bf16x8, pg8::pack8(x1 * c4 - x2 * s4, x2 * c4 + x1 * s4)); }
    f32x4 o[NVT];
#pragma unroll
    for (int i = 0; i < NVT; ++i) o[i] = (f32x4){0.f, 0.f, 0.f, 0.f};
    float mrow = -1e30f, lrow = 0.f;
    const int my_nkt = (wid < 4) ? nkt_lo : nkt;
    u32x4 kreg[KPT], vreg[VPT];
#define ATT_LOAD(KT_) do { const bf16_t* Kn = Kp + (size_t)(KT_) * 64 * ldk; const bf16_t* Vn = VT + (size_t)(KT_) * 64; \
        _Pragma("unroll") for (int i = 0; i < KPT; ++i) { const int p = tid + i * NT; if (p < KPC) { const int row = p / (DQK / 8), pc = p % (DQK / 8); kreg[i] = *(const u32x4*)(Kn + (size_t)row * ldk + pc * 8); } } \
        _Pragma("unroll") for (int i = 0; i < VPT; ++i) { const int p = tid + i * NT; if (p < VPC) { const int row = p >> 3, pc = p & 7; vreg[i] = *(const u32x4*)(Vn + (size_t)row * ldv + pc * 8); } } } while (0)
#define ATT_STORE(STG_) do { LAS unsigned char* kd = lds + (STG_) * ST_BYTES; LAS unsigned char* vd = kd + KT_BYTES; \
        _Pragma("unroll") for (int i = 0; i < KPT; ++i) { const int p = tid + i * NT; if (p < KPC) { const int row = p / (DQK / 8), pc = p % (DQK / 8); *(LAS u32x4*)(kd + (row * KST + pc * 8) * 2) = kreg[i]; } } \
        _Pragma("unroll") for (int i = 0; i < VPT; ++i) { const int p = tid + i * NT; if (p < VPC) { const int row = p >> 3, pc = p & 7; *(LAS u32x4*)(vd + (row * 72 + pc * 8) * 2) = vreg[i]; } } } while (0)
    __syncthreads();
    ATT_LOAD(0); ATT_STORE(0);
    __syncthreads();
    for (int kt = 0; kt < nkt; ++kt) {
        const int stg = (NST == 2) ? (kt & 1) : 0;
        LAS unsigned char* kt_l = lds + stg * ST_BYTES; LAS unsigned char* vt_l = kt_l + KT_BYTES;
        if (kt + 1 < nkt) ATT_LOAD(kt + 1);
        if (kt < my_nkt) {
            f32x4 st[4];
#pragma unroll
            for (int nt = 0; nt < 4; ++nt) { st[nt] = (f32x4){0.f, 0.f, 0.f, 0.f};
#pragma unroll
                for (int ks = 0; ks < KS; ++ks) st[nt] = MFMA16(lds_frag(kt_l + ((nt * 16 + r) * KST + ks * 32 + q * 8) * 2), qf[ks], st[nt]); }
            float mx = fmaxf(fmaxf(fmaxf(st[0][0], st[0][1]), fmaxf(st[0][2], st[0][3])), fmaxf(fmaxf(st[1][0], st[1][1]), fmaxf(st[1][2], st[1][3])));
            mx = fmaxf(mx, fmaxf(fmaxf(fmaxf(st[2][0], st[2][1]), fmaxf(st[2][2], st[2][3])), fmaxf(fmaxf(st[3][0], st[3][1]), fmaxf(st[3][2], st[3][3]))));
            mx = fmaxf(mx, bperm_f(mx, lane ^ 16)); mx = fmaxf(mx, bperm_f(mx, lane ^ 32));
            const float mn = fmaxf(mrow, mx), alpha = __builtin_amdgcn_exp2f(mrow - mn); mrow = mn; float rs = 0.f;
#pragma unroll
            for (int nt = 0; nt < 4; ++nt)
#pragma unroll
                for (int i = 0; i < 4; ++i) { const float p = __builtin_amdgcn_exp2f(st[nt][i] - mn); st[nt][i] = p; rs += p; }
            lrow = lrow * alpha + rs;
            bf16x8 pf[2];
#pragma unroll
            for (int ks2 = 0; ks2 < 2; ++ks2) pf[ks2] = __builtin_bit_cast(bf16x8, pg8::pack8(st[2 * ks2], st[2 * ks2 + 1]));
#pragma unroll
            for (int d = 0; d < NVT; ++d) { o[d] = o[d] * alpha;
#pragma unroll
                for (int ks2 = 0; ks2 < 2; ++ks2) { const LAS unsigned char* vp = vt_l + ((d * 16 + r) * 72 + ks2 * 32 + q * 4) * 2;
                    const u32x2 v0 = *(const LAS u32x2*)vp, v1 = *(const LAS u32x2*)(vp + 32);
                    const u32x4 vv = {v0.x, v0.y, v1.x, v1.y};
                    o[d] = MFMA16(__builtin_bit_cast(bf16x8, vv), pf[ks2], o[d]); } }
        }
        if (kt + 1 < nkt) {
            if constexpr (NST == 1) lds_barrier();
            ATT_STORE((NST == 2) ? ((kt + 1) & 1) : 0);
        }
        lds_barrier();
    }
#undef ATT_LOAD
#undef ATT_STORE
    { float ls = lrow; ls += bperm_f(ls, lane ^ 16); ls += bperm_f(ls, lane ^ 32); const float inv = 1.f / ls; bf16_t* yp = Y + (size_t)(wid * 16 + r) * ldy + q * 4;
#pragma unroll
        for (int d = 0; d < NVT; ++d) { u32x2 w; w.x = pk2(o[d][0] * inv, o[d][1] * inv); w.y = pk2(o[d][2] * inv, o[d][3] * inv); *(u32x2*)(yp + d * 16) = w; } }
}

struct LayerP {
    const float* ssd_conv_w; const float* ssd_conv_b; const float* ssd_dt_bias; const float* ssd_a_log; const float* ssd_d; const float* ssd_norm_g;
    const float* gdn_conv_w; const float* gdn_dt_bias; const float* gdn_a_log; const float* gdn_norm_g;
};
__device__ __forceinline__ void gdn_prep_item(LAS unsigned char* lds, const bf16_t* cols, const LayerP& P, bf16_t* GP, float* gdec, int item) {
    const int tid = tid_o(), wid = tid >> 6, lane = tid & 63, r = lane & 15, q = lane >> 4;
    const int h = item & 3, c = (item >> 2) & 63, b = item >> 8;
    LAS bf16_t* RAW = (LAS bf16_t*)lds;
    LAS float* QF = (LAS float*)(lds + 25856);
    LAS float* KF = QF + 64 * 65; LAS float* VF = KF + 64 * 65;
    LAS unsigned char* QB = lds + 75776; LAS unsigned char* KB = QB + 9216; LAS unsigned char* KBB = KB + 9216;
    LAS float* MM = (LAS float*)(lds + 103424);
    LAS float* BETA = (LAS float*)(lds + 120832); LAS float* GC = BETA + 64;
    const size_t tok0 = (size_t)b * SEQ + (size_t)c * 64;
    bf16_t* gp = GP + (size_t)item * (5 * 4096);
    bf16_t* gU = gp; bf16_t* gW = gp + 4096; bf16_t* gQK = gp + 8192; bf16_t* gQD = gp + 12288; bf16_t* gKDT = gp + 16384;
    lds_barrier();
    for (int i = tid; i < 67 * 24; i += NT) { const int rr = i / 24, rem = i % 24, p = rem >> 3, pc = rem & 7; const int t = c * 64 - 3 + rr;
        u32x4 v = (u32x4){0u, 0u, 0u, 0u};
        if (t >= 0) v = *(const u32x4*)(cols + ((size_t)b * SEQ + t) * LDC + GDN_QKV + p * 256 + h * 64 + pc * 8);
        *(LAS u32x4*)(RAW + rr * 192 + p * 64 + pc * 8) = v; }
    if (wid == 7) { const size_t tok = tok0 + lane;
        const float braw = bf2f(cols[tok * LDC + GDN_B + h]), araw = bf2f(cols[tok * LDC + GDN_A + h]);
        const float beta = __builtin_amdgcn_rcpf(1.f + __expf(-braw));
        float g = -__expf(P.gdn_a_log[h]) * softplus_f(araw + P.gdn_dt_bias[h]);
#pragma unroll
        for (int o = 1; o < 64; o <<= 1) { const float t = bperm_f(g, lane - o); if (lane >= o) g += t; }
        BETA[lane] = beta; GC[lane] = g; }
    lds_barrier();
    if (tid < 384) { const int ch = tid % 192, l0 = tid / 192, p = ch >> 6, d = ch & 63; const int C = p * 256 + h * 64 + d;
        const float w0 = P.gdn_conv_w[C], w1 = P.gdn_conv_w[768 + C], w2 = P.gdn_conv_w[1536 + C], w3 = P.gdn_conv_w[2304 + C];
        LAS float* F = QF + p * (64 * 65);
        const int lb = l0 * 32; float x0 = bf2f(RAW[lb * 192 + ch]), x1 = bf2f(RAW[(lb + 1) * 192 + ch]), x2 = bf2f(RAW[(lb + 2) * 192 + ch]);
#pragma unroll 4
        for (int j = 0; j < 32; ++j) { const int l = lb + j; const float x3 = bf2f(RAW[(l + 3) * 192 + ch]);
            F[l * 65 + d] = silu_f(w0 * x0 + w1 * x1 + w2 * x2 + w3 * x3); x0 = x1; x1 = x2; x2 = x3; } }
    lds_barrier();
    { const int row = tid >> 2, sub = tid & 3, which = row >> 6, l = row & 63; LAS float* F = (which ? KF : QF) + l * 65 + sub * 16; float s = 0.f;
#pragma unroll
        for (int j = 0; j < 16; ++j) s += F[j] * F[j];
        s += dppf<0xB1>(s); s += dppf<0x4E>(s);
        const float rn = __builtin_amdgcn_rsqf(s + EPS) * (which ? 1.f : 0.125f);
#pragma unroll
        for (int j = 0; j < 16; ++j) F[j] *= rn; }
    lds_barrier();
    { const int l = tid >> 3, d0 = (tid & 7) * 8; const float beta = BETA[l], eg = __expf(GC[l]);
        f32x4 qa, qb, ka, kb;
#pragma unroll
        for (int j = 0; j < 4; ++j) { qa[j] = QF[l * 65 + d0 + j]; qb[j] = QF[l * 65 + d0 + 4 + j]; ka[j] = KF[l * 65 + d0 + j]; kb[j] = KF[l * 65 + d0 + 4 + j]; }
        *(LAS u32x4*)(QB + (l * 72 + d0) * 2) = pg8::pack8(qa, qb);
        *(LAS u32x4*)(KB + (l * 72 + d0) * 2) = pg8::pack8(ka, kb);
        *(LAS u32x4*)(KBB + (l * 72 + d0) * 2) = pg8::pack8(ka * beta, kb * beta);
        *(u32x4*)(gQD + l * 64 + d0) = pg8::pack8(qa * eg, qb * eg);
        const int d = tid >> 3, l0 = (tid & 7) * 8; const float gl = GC[63]; f32x4 ta, tb;
#pragma unroll
        for (int j = 0; j < 4; ++j) { ta[j] = KF[(l0 + j) * 65 + d] * __expf(gl - GC[l0 + j]); tb[j] = KF[(l0 + 4 + j) * 65 + d] * __expf(gl - GC[l0 + 4 + j]); }
        *(u32x4*)(gKDT + d * 64 + l0) = pg8::pack8(ta, tb);
        if (tid == 0) gdec[item] = __expf(gl); }
    lds_barrier();
    { const int lt = wid >> 1;
#pragma unroll
        for (int t = 0; t < 2; ++t) { const int st = (wid & 1) * 2 + t; f32x4 akk = (f32x4){0.f, 0.f, 0.f, 0.f}, aqk = akk;
#pragma unroll
            for (int ks = 0; ks < 2; ++ks) { const bf16x8 bfr = lds_frag(KB + ((st * 16 + r) * 72 + ks * 32 + q * 8) * 2);
                akk = MFMA16(lds_frag(KBB + ((lt * 16 + r) * 72 + ks * 32 + q * 8) * 2), bfr, akk);
                aqk = MFMA16(lds_frag(QB + ((lt * 16 + r) * 72 + ks * 32 + q * 8) * 2), bfr, aqk); }
            const int s = st * 16 + r; const float gs = GC[s]; f32x4 mmv;
#pragma unroll
            for (int i = 0; i < 4; ++i) { const int l = lt * 16 + q * 4 + i; const float gam = (s <= l) ? __expf(GC[l] - gs) : 0.f;
                mmv[i] = (s < l) ? akk[i] * gam : 0.f;
                gQK[l * 64 + s] = (bf16_t)f2bf((s <= l) ? aqk[i] * gam : 0.f); }
            *(LAS f32x4*)(MM + s * 68 + lt * 16 + q * 4) = mmv; } }
    lds_barrier();
    { const int col = tid >> 2, k = tid & 3, j = col & 63; const bool isw = col >= 64; LAS float* SRC = isw ? KF : VF; LAS float* XL = (LAS float*)lds;
        bf16_t* dst = (isw ? gW : gU) + j;
#pragma unroll
        for (int bI = 0; bI < 4; ++bI) { const int lb = bI * 16 + 4 * k; float acc[4];
#pragma unroll
            for (int e = 0; e < 4; ++e) { const int l = lb + e; float a = SRC[l * 65 + j] * BETA[l]; if (isw) a *= __expf(GC[l]); acc[e] = a; }
            f32x4 dg[16];
#pragma unroll
            for (int i = 0; i < 16; ++i) dg[i] = *(const LAS f32x4*)(MM + (bI * 16 + i) * 68 + lb);
#pragma unroll 4
            for (int s = 0; s < bI * 16; ++s) { const float xs = XL[s * 128 + col]; const f32x4 mv = *(const LAS f32x4*)(MM + s * 68 + lb);
#pragma unroll
                for (int e = 0; e < 4; ++e) acc[e] -= mv[e] * xs; }
#pragma unroll
            for (int i = 0; i < 16; ++i) { const float own = acc[i & 3];
                const float xv = (i / 4 == 0) ? dppf<0x00>(own) : (i / 4 == 1) ? dppf<0x55>(own) : (i / 4 == 2) ? dppf<0xAA>(own) : dppf<0xFF>(own);
#pragma unroll
                for (int e = 0; e < 4; ++e) acc[e] -= dg[i][e] * xv; }
#pragma unroll
            for (int e = 0; e < 4; ++e) { const int l = lb + e; if (bI < 3) XL[l * 128 + col] = acc[e]; dst[l * 64] = (bf16_t)f2bf(acc[e]); } } }
    lds_barrier();
}

__device__ __forceinline__ void gdn_scan_item(LAS unsigned char* lds, const bf16_t* cols, const LayerP& P, const bf16_t* GP, const float* gdec, bf16_t* Y, int item) {
    const int tid = tid_o(), wid = tid >> 6, lane = tid & 63, r = lane & 15, q = lane >> 4;
    const int h = item & 3, b = item >> 2;
    constexpr int MB = 9216, DBB = 5 * MB;
    LAS unsigned char* DB = lds; LAS unsigned char* ST = lds + 2 * DBB; LAS unsigned char* VN = ST + MB; LAS float* OB = (LAS float*)(VN + MB);
    const int lt = wid >> 1, vt0 = (wid & 1) * 2;
    const int prow = tid >> 3, pcol = (tid & 7) * 8;
    f32x4 sacc[2] = {(f32x4){0.f, 0.f, 0.f, 0.f}, (f32x4){0.f, 0.f, 0.f, 0.f}};
    __syncthreads();
    for (int i = tid; i < MB / 4; i += NT) ((LAS unsigned*)ST)[i] = 0u;
    u32x4 pre[2][5];
    { const bf16_t* gp = GP + (size_t)((b * 64 + 0) * 4 + h) * (5 * 4096);
#pragma unroll
        for (int m = 0; m < 5; ++m) pre[0][m] = *(const u32x4*)(gp + m * 4096 + prow * 64 + pcol);
#pragma unroll
        for (int m = 0; m < 5; ++m) pre[1][m] = *(const u32x4*)(gp + 5 * 4096 * 4 + m * 4096 + prow * 64 + pcol);
#pragma unroll
        for (int m = 0; m < 5; ++m) *(LAS u32x4*)(DB + m * MB + (prow * 72 + pcol) * 2) = pre[0][m]; }
    __syncthreads();
    const int fl = tid >> 3, fv0 = (tid & 7) * 8;
    const f32x4 ga = *(const f32x4*)(P.gdn_norm_g + fv0), gb = *(const f32x4*)(P.gdn_norm_g + fv0 + 4);
    u32x4 zn = *(const u32x4*)(cols + ((size_t)b * SEQ + fl) * LDC + GDN_Z + h * 64 + fv0);
    float decn = gdec[(b * 64 + 0) * 4 + h];
    for (int c2 = 0; c2 < 64; c2 += 2) {
#pragma unroll
      for (int u = 0; u < 2; ++u) { const int c = c2 + u;
        const u32x4 zz = zn; const float dec = decn;
        if (c + 1 < 64) { zn = *(const u32x4*)(cols + ((size_t)b * SEQ + (c + 1) * 64 + fl) * LDC + GDN_Z + h * 64 + fv0); decn = gdec[(b * 64 + c + 1) * 4 + h]; }
        LAS unsigned char* cur = DB + u * DBB; LAS unsigned char* nxt = DB + (u ^ 1) * DBB;
        LAS unsigned char* mU = cur; LAS unsigned char* mW = cur + MB; LAS unsigned char* mQK = cur + 2 * MB; LAS unsigned char* mQD = cur + 3 * MB; LAS unsigned char* mKDT = cur + 4 * MB;
        if (c + 2 < 64) { const bf16_t* gp = GP + (size_t)((b * 64 + c + 2) * 4 + h) * (5 * 4096);
#pragma unroll
            for (int m = 0; m < 5; ++m) pre[u][m] = *(const u32x4*)(gp + m * 4096 + prow * 64 + pcol); }
        f32x4 ao[2];
#pragma unroll
        for (int t = 0; t < 2; ++t) { const int vt = vt0 + t; f32x4 aws = (f32x4){0.f, 0.f, 0.f, 0.f}; ao[t] = aws;
#pragma unroll
            for (int ks = 0; ks < 2; ++ks) { const bf16x8 bfr = lds_frag(ST + ((vt * 16 + r) * 72 + ks * 32 + q * 8) * 2);
                aws = MFMA16(lds_frag(mW + ((lt * 16 + r) * 72 + ks * 32 + q * 8) * 2), bfr, aws);
                ao[t] = MFMA16(lds_frag(mQD + ((lt * 16 + r) * 72 + ks * 32 + q * 8) * 2), bfr, ao[t]); }
            f32x4 vn;
#pragma unroll
            for (int i = 0; i < 4; ++i) vn[i] = bf2f(*(const LAS bf16_t*)(mU + ((lt * 16 + q * 4 + i) * 72 + vt * 16 + r) * 2)) - aws[i];
            u32x2 w2; w2.x = pk2(vn[0], vn[1]); w2.y = pk2(vn[2], vn[3]);
            *(LAS u32x2*)(VN + ((vt * 16 + r) * 72 + lt * 16 + q * 4) * 2) = w2; }
        lds_barrier();
#pragma unroll
        for (int t = 0; t < 2; ++t) { const int vt = vt0 + t; sacc[t] = sacc[t] * dec;
#pragma unroll
            for (int ks = 0; ks < 2; ++ks) { const bf16x8 bfr = lds_frag(VN + ((vt * 16 + r) * 72 + ks * 32 + q * 8) * 2);
                ao[t] = MFMA16(lds_frag(mQK + ((lt * 16 + r) * 72 + ks * 32 + q * 8) * 2), bfr, ao[t]);
                sacc[t] = MFMA16(lds_frag(mKDT + ((lt * 16 + r) * 72 + ks * 32 + q * 8) * 2), bfr, sacc[t]); }
#pragma unroll
            for (int i = 0; i < 4; ++i) OB[(lt * 16 + q * 4 + i) * 68 + vt * 16 + r] = ao[t][i];
            u32x2 w2; w2.x = pk2(sacc[t][0], sacc[t][1]); w2.y = pk2(sacc[t][2], sacc[t][3]);
            *(LAS u32x2*)(ST + ((vt * 16 + r) * 72 + lt * 16 + q * 4) * 2) = w2; }
        if (c + 1 < 64) {
#pragma unroll
            for (int m = 0; m < 5; ++m) *(LAS u32x4*)(nxt + m * MB + (prow * 72 + pcol) * 2) = pre[u ^ 1][m]; }
        lds_barrier();
        { const int l = tid >> 3, v0 = (tid & 7) * 8; const size_t tok = (size_t)b * SEQ + c * 64 + l;
            const f32x4 oa = *(const LAS f32x4*)(OB + l * 68 + v0), ob = *(const LAS f32x4*)(OB + l * 68 + v0 + 4);
            float s = 0.f;
#pragma unroll
            for (int j = 0; j < 4; ++j) s += oa[j] * oa[j] + ob[j] * ob[j];
            s = row8_sum(s);
            const float rs = __builtin_amdgcn_rsqf(s * (1.f / 64.f) + EPS);
            f32x4 ra, rb;
            ra[0] = oa[0] * rs * ga[0] * silu_f(bflo(zz.x)); ra[1] = oa[1] * rs * ga[1] * silu_f(bfhi(zz.x));
            ra[2] = oa[2] * rs * ga[2] * silu_f(bflo(zz.y)); ra[3] = oa[3] * rs * ga[3] * silu_f(bfhi(zz.y));
            rb[0] = ob[0] * rs * gb[0] * silu_f(bflo(zz.z)); rb[1] = ob[1] * rs * gb[1] * silu_f(bfhi(zz.z));
            rb[2] = ob[2] * rs * gb[2] * silu_f(bflo(zz.w)); rb[3] = ob[3] * rs * gb[3] * silu_f(bfhi(zz.w));
            *(u32x4*)(Y + tok * 1024 + 768 + h * 64 + v0) = pg8::pack8(ra, rb); }
      }
    }
    __syncthreads();
}

__device__ __forceinline__ void ssd_scan_item(LAS unsigned char* lds, const bf16_t* cols, const LayerP& P, bf16_t* Y, float* ssdp, int item) {
    const int tid = tid_o(), wid = tid >> 6, lane = tid & 63, r = lane & 15, q = lane >> 4;
    const int hd = item & 7, b = item >> 3, g = hd >> 2;
    constexpr int MB = 9216;
    LAS bf16_t* RAW = (LAS bf16_t*)lds;
    LAS unsigned char* XT = lds + 25856; LAS unsigned char* BM_ = XT + MB; LAS unsigned char* BTS = BM_ + MB; LAS unsigned char* CM = BTS + MB;
    LAS unsigned char* HC = CM + MB; LAS unsigned char* GM = HC + MB;
    LAS float* DT = (LAS float*)(GM + MB); LAS float* AC = DT + 64;
    const int lt = wid >> 1, pt0 = (wid & 1) * 2;
    const float a_h = -__expf(P.ssd_a_log[hd]), dtb = P.ssd_dt_bias[hd], dsk = P.ssd_d[hd];
    const int ch = tid % 192, l0 = tid / 192;
    int cc;
    if (ch < 64) cc = hd * 64 + ch; else if (ch < 128) cc = 512 + g * 64 + (ch - 64); else cc = 640 + g * 64 + (ch - 128);
    float w0 = 0.f, w1 = 0.f, w2 = 0.f, w3 = 0.f, cb = 0.f;
    if (tid < 384) { w0 = P.ssd_conv_w[cc]; w1 = P.ssd_conv_w[768 + cc]; w2 = P.ssd_conv_w[1536 + cc]; w3 = P.ssd_conv_w[2304 + cc]; cb = P.ssd_conv_b[cc]; }
    f32x4 hacc[2] = {(f32x4){0.f, 0.f, 0.f, 0.f}, (f32x4){0.f, 0.f, 0.f, 0.f}};
    __syncthreads();
    for (int i = tid; i < MB / 4; i += NT) ((LAS unsigned*)HC)[i] = 0u;
    u32x4 pre[4];
#define SSD_LOAD_RAW(cidx) do { _Pragma("unroll") for (int k = 0; k < 4; ++k) { const int i = tid + k * NT; pre[k] = (u32x4){0u, 0u, 0u, 0u}; \
        if (i < 67 * 24) { const int rr = i / 24, rem = i % 24, p = rem >> 3, pc = rem & 7; const int t = (cidx) * 64 - 3 + rr; \
            const int colb = (p == 0) ? (SSD_XBC + hd * 64) : (p == 1 ? SSD_XBC + 512 + g * 64 : SSD_XBC + 640 + g * 64); \
            if (t >= 0) pre[k] = *(const u32x4*)(cols + ((size_t)b * SEQ + t) * LDC + colb + pc * 8); } } } while (0)
#define SSD_STORE_RAW() do { _Pragma("unroll") for (int k = 0; k < 4; ++k) { const int i = tid + k * NT; \
        if (i < 67 * 24) { const int rr = i / 24, rem = i % 24, p = rem >> 3, pc = rem & 7; *(LAS u32x4*)(RAW + rr * 192 + p * 64 + pc * 8) = pre[k]; } } } while (0)
    SSD_LOAD_RAW(0); SSD_STORE_RAW();
    float dtrn = 0.f; if (wid == 6) dtrn = bf2f(cols[((size_t)b * SEQ + lane) * LDC + SSD_DT + hd]);
    bf16_t zn[8];
#pragma unroll
    for (int t = 0; t < 2; ++t)
#pragma unroll
        for (int i = 0; i < 4; ++i) zn[t * 4 + i] = cols[((size_t)b * SEQ + lt * 16 + q * 4 + i) * LDC + SSD_Z + hd * 64 + (pt0 + t) * 16 + r];
    __syncthreads();
    for (int c = 0; c < 64; ++c) {
        const size_t tok0 = (size_t)b * SEQ + (size_t)c * 64;
        if (c + 1 < 64) SSD_LOAD_RAW(c + 1);
        bf16_t zc[8];
#pragma unroll
        for (int k = 0; k < 8; ++k) zc[k] = zn[k];
        if (c + 1 < 64) {
#pragma unroll
            for (int t = 0; t < 2; ++t)
#pragma unroll
                for (int i = 0; i < 4; ++i) zn[t * 4 + i] = cols[(tok0 + 64 + lt * 16 + q * 4 + i) * LDC + SSD_Z + hd * 64 + (pt0 + t) * 16 + r]; }
        if (tid < 384) {
            const int lb = l0 * 32; float x0 = bf2f(RAW[lb * 192 + ch]), x1 = bf2f(RAW[(lb + 1) * 192 + ch]), x2 = bf2f(RAW[(lb + 2) * 192 + ch]);
#pragma unroll 4
            for (int j = 0; j < 32; ++j) { const int l = lb + j; const float x3 = bf2f(RAW[(l + 3) * 192 + ch]);
                const float y = silu_f(cb + w0 * x0 + w1 * x1 + w2 * x2 + w3 * x3); x0 = x1; x1 = x2; x2 = x3;
                const bf16_t yb = (bf16_t)f2bf(y);
                if (ch < 64) *(LAS bf16_t*)(XT + (ch * 72 + l) * 2) = yb;
                else if (ch < 128) *(LAS bf16_t*)(BM_ + (l * 72 + ch - 64) * 2) = yb;
                else *(LAS bf16_t*)(CM + (l * 72 + ch - 128) * 2) = yb; }
        } else if (wid == 6) {
            const float dt = softplus_f(dtrn + dtb); float ac = dt * a_h;
#pragma unroll
            for (int o = 1; o < 64; o <<= 1) { const float t = bperm_f(ac, lane - o); if (lane >= o) ac += t; }
            DT[lane] = dt; AC[lane] = ac;
            if (c + 1 < 64) dtrn = bf2f(cols[(tok0 + 64 + lane) * LDC + SSD_DT + hd]); }
        __syncthreads();
        const float ac63 = AC[63];
        { const int n = tid >> 3, lb = (tid & 7) * 8; f32x4 ta, tb;
#pragma unroll
            for (int j = 0; j < 4; ++j) { ta[j] = bf2f(*(const LAS bf16_t*)(BM_ + ((lb + j) * 72 + n) * 2)) * DT[lb + j] * __expf(ac63 - AC[lb + j]);
                tb[j] = bf2f(*(const LAS bf16_t*)(BM_ + ((lb + 4 + j) * 72 + n) * 2)) * DT[lb + 4 + j] * __expf(ac63 - AC[lb + 4 + j]); }
            *(LAS u32x4*)(BTS + (n * 72 + lb) * 2) = pg8::pack8(ta, tb); }
#pragma unroll
        for (int t = 0; t < 2; ++t) { const int st = pt0 + t; f32x4 a = (f32x4){0.f, 0.f, 0.f, 0.f};
#pragma unroll
            for (int ks = 0; ks < 2; ++ks) a = MFMA16(lds_frag(CM + ((lt * 16 + r) * 72 + ks * 32 + q * 8) * 2), lds_frag(BM_ + ((st * 16 + r) * 72 + ks * 32 + q * 8) * 2), a);
            const int s = st * 16 + r; const float as = AC[s], ds = DT[s];
#pragma unroll
            for (int i = 0; i < 4; ++i) { const int l = lt * 16 + q * 4 + i; const float gv = (s <= l) ? a[i] * __expf(AC[l] - as) * ds : 0.f;
                *(LAS bf16_t*)(GM + (l * 72 + s) * 2) = (bf16_t)f2bf(gv); } }
        __syncthreads();
        float ssq[4] = {0.f, 0.f, 0.f, 0.f};
#pragma unroll
        for (int t = 0; t < 2; ++t) { const int pt = pt0 + t; f32x4 yd = (f32x4){0.f, 0.f, 0.f, 0.f}, yo = yd;
#pragma unroll
            for (int ks = 0; ks < 2; ++ks) {
                yd = MFMA16(lds_frag(GM + ((lt * 16 + r) * 72 + ks * 32 + q * 8) * 2), lds_frag(XT + ((pt * 16 + r) * 72 + ks * 32 + q * 8) * 2), yd);
                yo = MFMA16(lds_frag(CM + ((lt * 16 + r) * 72 + ks * 32 + q * 8) * 2), lds_frag(HC + ((pt * 16 + r) * 72 + ks * 32 + q * 8) * 2), yo); }
            const int p = pt * 16 + r; const u32x2 xw = *(const LAS u32x2*)(XT + (p * 72 + lt * 16 + q * 4) * 2);
            const float xs4[4] = {bflo(xw.x), bfhi(xw.x), bflo(xw.y), bfhi(xw.y)};
#pragma unroll
            for (int i = 0; i < 4; ++i) { const int l = lt * 16 + q * 4 + i; const size_t tok = tok0 + l;
                float y = yd[i] + __expf(AC[l]) * yo[i] + dsk * xs4[i];
                y *= silu_f(bf2f(zc[t * 4 + i]));
                ssq[i] += y * y;
                Y[tok * 1024 + hd * 64 + p] = (bf16_t)f2bf(y); } }
#pragma unroll
        for (int i = 0; i < 4; ++i) { float s = ssq[i]; s += __shfl_xor(s, 1); s += __shfl_xor(s, 2); s += __shfl_xor(s, 4); s += __shfl_xor(s, 8);
            if (r == 0) ssdp[(tok0 + lt * 16 + q * 4 + i) * 16 + hd * 2 + (wid & 1)] = s; }
        { const float dec = __expf(ac63);
#pragma unroll
            for (int t = 0; t < 2; ++t) { const int pt = pt0 + t; hacc[t] = hacc[t] * dec;
#pragma unroll
                for (int ks = 0; ks < 2; ++ks) hacc[t] = MFMA16(lds_frag(BTS + ((lt * 16 + r) * 72 + ks * 32 + q * 8) * 2), lds_frag(XT + ((pt * 16 + r) * 72 + ks * 32 + q * 8) * 2), hacc[t]); } }
        __syncthreads();
#pragma unroll
        for (int t = 0; t < 2; ++t) { const int pt = pt0 + t; u32x2 w2; w2.x = pk2(hacc[t][0], hacc[t][1]); w2.y = pk2(hacc[t][2], hacc[t][3]);
            *(LAS u32x2*)(HC + ((pt * 16 + r) * 72 + lt * 16 + q * 4) * 2) = w2; }
        if (c + 1 < 64) SSD_STORE_RAW();
        __syncthreads();
    }
#undef SSD_LOAD_RAW
#undef SSD_STORE_RAW
}

__device__ __forceinline__ void ssd_prep_range(LAS unsigned char* lds, const bf16_t* cols, const LayerP& P, bf16_t* Y, bf16_t* SST, float* SAC, bf16_t* CMS, int b, int hd, int c0, int c1) {
    const int tid = tid_o(), wid = tid >> 6, lane = tid & 63, r = lane & 15, q = lane >> 4;
    const int g = hd >> 2;
    constexpr int MB = 9216;
    LAS bf16_t* RAW = (LAS bf16_t*)lds;
    LAS unsigned char* XT = lds + 25856; LAS unsigned char* BM_ = XT + MB; LAS unsigned char* BTS = BM_ + MB; LAS unsigned char* CM = BTS + MB; LAS unsigned char* GM = CM + MB;
    LAS float* DT = (LAS float*)(GM + MB); LAS float* AC = DT + 64;
    const int lt = wid >> 1, pt0 = (wid & 1) * 2;
    const float a_h = -__expf(P.ssd_a_log[hd]), dtb = P.ssd_dt_bias[hd], dsk = P.ssd_d[hd];
    const int ch = tid % 192, l0 = tid / 192;
    int cc;
    if (ch < 64) cc = hd * 64 + ch; else if (ch < 128) cc = 512 + g * 64 + (ch - 64); else cc = 640 + g * 64 + (ch - 128);
    float w0 = 0.f, w1 = 0.f, w2 = 0.f, w3 = 0.f, cb = 0.f;
    if (tid < 384) { w0 = P.ssd_conv_w[cc]; w1 = P.ssd_conv_w[768 + cc]; w2 = P.ssd_conv_w[1536 + cc]; w3 = P.ssd_conv_w[2304 + cc]; cb = P.ssd_conv_b[cc]; }
    u32x4 pre[4];
#define SSD_LOAD_RAW(cidx) do { _Pragma("unroll") for (int k = 0; k < 4; ++k) { const int i = tid + k * NT; pre[k] = (u32x4){0u, 0u, 0u, 0u}; \
        if (i < 67 * 24) { const int rr = i / 24, rem = i % 24, p = rem >> 3, pc = rem & 7; const int t = (cidx) * 64 - 3 + rr; \
            const int colb = (p == 0) ? (SSD_XBC + hd * 64) : (p == 1 ? SSD_XBC + 512 + g * 64 : SSD_XBC + 640 + g * 64); \
            if (t >= 0) pre[k] = *(const u32x4*)(cols + ((size_t)b * SEQ + t) * LDC + colb + pc * 8); } } } while (0)
#define SSD_STORE_RAW() do { _Pragma("unroll") for (int k = 0; k < 4; ++k) { const int i = tid + k * NT; \
        if (i < 67 * 24) { const int rr = i / 24, rem = i % 24, p = rem >> 3, pc = rem & 7; *(LAS u32x4*)(RAW + rr * 192 + p * 64 + pc * 8) = pre[k]; } } } while (0)
    __syncthreads();
    SSD_LOAD_RAW(c0); SSD_STORE_RAW();
    float dtrn = 0.f; if (wid == 6) dtrn = bf2f(cols[((size_t)b * SEQ + c0 * 64 + lane) * LDC + SSD_DT + hd]);
    __syncthreads();
    for (int c = c0; c < c1; ++c) {
        const size_t tok0 = (size_t)b * SEQ + (size_t)c * 64; const size_t it = (size_t)(b * 8 + hd) * 64 + c;
        if (c + 1 < c1) SSD_LOAD_RAW(c + 1);
        if (tid < 384) {
            const int lb = l0 * 32; float x0 = bf2f(RAW[lb * 192 + ch]), x1 = bf2f(RAW[(lb + 1) * 192 + ch]), x2 = bf2f(RAW[(lb + 2) * 192 + ch]);
#pragma unroll 4
            for (int j = 0; j < 32; ++j) { const int l = lb + j; const float x3 = bf2f(RAW[(l + 3) * 192 + ch]);
                const float y = silu_f(cb + w0 * x0 + w1 * x1 + w2 * x2 + w3 * x3); x0 = x1; x1 = x2; x2 = x3;
                const bf16_t yb = (bf16_t)f2bf(y);
                if (ch < 64) *(LAS bf16_t*)(XT + (ch * 72 + l) * 2) = yb;
                else if (ch < 128) *(LAS bf16_t*)(BM_ + (l * 72 + ch - 64) * 2) = yb;
                else *(LAS bf16_t*)(CM + (l * 72 + ch - 128) * 2) = yb; }
        } else if (wid == 6) {
            const float dt = softplus_f(dtrn + dtb); float ac = dt * a_h;
#pragma unroll
            for (int o = 1; o < 64; o <<= 1) { const float t = bperm_f(ac, lane - o); if (lane >= o) ac += t; }
            DT[lane] = dt; AC[lane] = ac; SAC[it * 64 + lane] = ac;
            if (c + 1 < c1) dtrn = bf2f(cols[(tok0 + 64 + lane) * LDC + SSD_DT + hd]); }
        lds_barrier();
        const float ac63 = AC[63];
        { const int n = tid >> 3, lb = (tid & 7) * 8; f32x4 ta, tb;
#pragma unroll
            for (int j = 0; j < 4; ++j) { ta[j] = bf2f(*(const LAS bf16_t*)(BM_ + ((lb + j) * 72 + n) * 2)) * DT[lb + j] * __expf(ac63 - AC[lb + j]);
                tb[j] = bf2f(*(const LAS bf16_t*)(BM_ + ((lb + 4 + j) * 72 + n) * 2)) * DT[lb + 4 + j] * __expf(ac63 - AC[lb + 4 + j]); }
            *(LAS u32x4*)(BTS + (n * 72 + lb) * 2) = pg8::pack8(ta, tb);
            if ((hd & 3) == 0) *(u32x4*)(CMS + ((size_t)((b * 64 + c) * 2 + g)) * 4096 + n * 64 + lb) = *(const LAS u32x4*)(CM + (n * 72 + lb) * 2); }
#pragma unroll
        for (int t = 0; t < 2; ++t) { const int st = pt0 + t; f32x4 a = (f32x4){0.f, 0.f, 0.f, 0.f};
#pragma unroll
            for (int ks = 0; ks < 2; ++ks) a = MFMA16(lds_frag(CM + ((lt * 16 + r) * 72 + ks * 32 + q * 8) * 2), lds_frag(BM_ + ((st * 16 + r) * 72 + ks * 32 + q * 8) * 2), a);
            const int s_ = st * 16 + r; const float as = AC[s_], ds = DT[s_];
#pragma unroll
            for (int i = 0; i < 4; ++i) { const int l = lt * 16 + q * 4 + i; const float gv = (s_ <= l) ? a[i] * __expf(AC[l] - as) * ds : 0.f;
                *(LAS bf16_t*)(GM + (l * 72 + s_) * 2) = (bf16_t)f2bf(gv); } }
        lds_barrier();
#pragma unroll
        for (int t = 0; t < 2; ++t) { const int pt = pt0 + t; f32x4 yd = (f32x4){0.f, 0.f, 0.f, 0.f}, sc = yd;
#pragma unroll
            for (int ks = 0; ks < 2; ++ks) {
                const bf16x8 xf = lds_frag(XT + ((pt * 16 + r) * 72 + ks * 32 + q * 8) * 2);
                yd = MFMA16(lds_frag(GM + ((lt * 16 + r) * 72 + ks * 32 + q * 8) * 2), xf, yd);
                sc = MFMA16(lds_frag(BTS + ((lt * 16 + r) * 72 + ks * 32 + q * 8) * 2), xf, sc); }
            const int p = pt * 16 + r; const u32x2 xw = *(const LAS u32x2*)(XT + (p * 72 + lt * 16 + q * 4) * 2);
            const float xs4[4] = {bflo(xw.x), bfhi(xw.x), bflo(xw.y), bfhi(xw.y)};
#pragma unroll
            for (int i = 0; i < 4; ++i) Y[(tok0 + lt * 16 + q * 4 + i) * 1024 + hd * 64 + p] = (bf16_t)f2bf(yd[i] + dsk * xs4[i]);
            u32x2 w2; w2.x = pk2(sc[0], sc[1]); w2.y = pk2(sc[2], sc[3]);
            *(u32x2*)(SST + it * 4096 + p * 64 + lt * 16 + q * 4) = w2; }
        if (c + 1 < c1) SSD_STORE_RAW();
        lds_barrier();
    }
#undef SSD_LOAD_RAW
#undef SSD_STORE_RAW
}
__device__ __forceinline__ void ssd_state_scan_item(LAS unsigned char* lds, bf16_t* SST, const float* SAC, int item) {
    const int tid = tid_o(); LAS float* DEC = (LAS float*)lds;
    __syncthreads();
    if (tid < 64) DEC[tid] = __expf(SAC[((size_t)item * 64 + tid) * 64 + 63]);
    __syncthreads();
    bf16_t* base = SST + (size_t)item * 64 * 4096 + tid * 8;
    f32x4 ha = (f32x4){0.f, 0.f, 0.f, 0.f}, hb2 = ha;
    u32x4 sv[4];
#pragma unroll
    for (int k = 0; k < 4; ++k) sv[k] = *(const u32x4*)(base + (size_t)k * 4096);
    for (int c4 = 0; c4 < 64; c4 += 4) {
#pragma unroll
        for (int k = 0; k < 4; ++k) { const int c = c4 + k; const u32x4 w = sv[k];
            if (c + 4 < 64) sv[k] = *(const u32x4*)(base + (size_t)(c + 4) * 4096);
            *(u32x4*)(base + (size_t)c * 4096) = pg8::pack8(ha, hb2);
            const float d = DEC[c];
            ha[0] = ha[0] * d + bflo(w.x); ha[1] = ha[1] * d + bfhi(w.x); ha[2] = ha[2] * d + bflo(w.y); ha[3] = ha[3] * d + bfhi(w.y);
            hb2[0] = hb2[0] * d + bflo(w.z); hb2[1] = hb2[1] * d + bfhi(w.z); hb2[2] = hb2[2] * d + bflo(w.w); hb2[3] = hb2[3] * d + bfhi(w.w); } }
}
__device__ __forceinline__ void ssd_finish_item(LAS unsigned char* lds, const bf16_t* cols, const float* ng, bf16_t* Y, const bf16_t* SST, const float* SAC, const bf16_t* CMS, int item) {
    const int tid = tid_o(), wid = tid >> 6, lane = tid & 63, r = lane & 15, q = lane >> 4;
    const int g = item & 1, c = (item >> 1) & 63, b = item >> 7;
    constexpr int MB = 9216;
    LAS unsigned char* CM = lds; LAS unsigned char* HC = lds + MB; LAS float* ACS = (LAS float*)(lds + 5 * MB); LAS float* SSQ = ACS + 256;
    const int prow = tid >> 3, pcol = (tid & 7) * 8;
    lds_barrier();
    *(LAS u32x4*)(CM + (prow * 72 + pcol) * 2) = *(const u32x4*)(CMS + (size_t)item * 4096 + prow * 64 + pcol);
#pragma unroll
    for (int hh = 0; hh < 4; ++hh) *(LAS u32x4*)(HC + hh * MB + (prow * 72 + pcol) * 2) = *(const u32x4*)(SST + ((size_t)(b * 8 + g * 4 + hh) * 64 + c) * 4096 + prow * 64 + pcol);
    if (tid < 256) ACS[tid] = SAC[((size_t)(b * 8 + g * 4 + (tid >> 6)) * 64 + c) * 64 + (tid & 63)];
    lds_barrier();
    const int hh = wid >> 1, half = wid & 1, hd = g * 4 + hh; const size_t tok0 = (size_t)b * SEQ + (size_t)c * 64;
    float yv[2][4][4]; float ssq[2][4];
#pragma unroll
    for (int a = 0; a < 2; ++a) { const int lt = half * 2 + a;
#pragma unroll
        for (int i = 0; i < 4; ++i) ssq[a][i] = 0.f;
#pragma unroll
        for (int pt = 0; pt < 4; ++pt) { f32x4 yo = (f32x4){0.f, 0.f, 0.f, 0.f};
#pragma unroll
            for (int ks = 0; ks < 2; ++ks) yo = MFMA16(lds_frag(CM + ((lt * 16 + r) * 72 + ks * 32 + q * 8) * 2), lds_frag(HC + hh * MB + ((pt * 16 + r) * 72 + ks * 32 + q * 8) * 2), yo);
            const int p = pt * 16 + r;
#pragma unroll
            for (int i = 0; i < 4; ++i) { const int l = lt * 16 + q * 4 + i; const size_t tok = tok0 + l;
                float y = bf2f(Y[tok * 1024 + hd * 64 + p]) + __expf(ACS[hh * 64 + l]) * yo[i];
                y *= silu_f(bf2f(cols[tok * LDC + SSD_Z + hd * 64 + p]));
                yv[a][pt][i] = y; ssq[a][i] += y * y; } }
#pragma unroll
        for (int i = 0; i < 4; ++i) { float s_ = row16_sum(ssq[a][i]);
            if (r == 0) SSQ[(lt * 16 + q * 4 + i) * 4 + hh] = s_; } }
    lds_barrier();
#pragma unroll
    for (int a = 0; a < 2; ++a) { const int lt = half * 2 + a;
#pragma unroll
        for (int i = 0; i < 4; ++i) { const int l = lt * 16 + q * 4 + i; const f32x4 sq = *(const LAS f32x4*)(SSQ + l * 4);
            const float rs = __builtin_amdgcn_rsqf(((sq[0] + sq[1]) + (sq[2] + sq[3])) * (1.f / 256.f) + EPS);
#pragma unroll
            for (int pt = 0; pt < 4; ++pt) { const int p = pt * 16 + r; Y[(tok0 + l) * 1024 + hd * 64 + p] = (bf16_t)f2bf(yv[a][pt][i] * rs * ng[hd * 64 + p]); } } }
}

__device__ __forceinline__ void ssd_fixup(bf16_t* Y, const float* ssdp, const float* ng) {
    const int gt = bid_o() * NT + tid_o(), gn = gridDim.x * NT;
    for (int i = gt; i < T * 64; i += gn) { const int tok = i >> 6, c0 = (i & 63) * 8, g = c0 >> 8;
        const f32x4 pa = *(const f32x4*)(ssdp + (size_t)tok * 16 + g * 8), pb = *(const f32x4*)(ssdp + (size_t)tok * 16 + g * 8 + 4);
        const float s = (pa[0] + pa[1]) + (pa[2] + pa[3]) + (pb[0] + pb[1]) + (pb[2] + pb[3]);
        const float rs = __builtin_amdgcn_rsqf(s * (1.f / 256.f) + EPS);
        bf16_t* yp = Y + (size_t)tok * 1024 + c0; const u32x4 v = *(const u32x4*)yp;
        const f32x4 ga = *(const f32x4*)(ng + c0), gb = *(const f32x4*)(ng + c0 + 4);
        f32x4 a, b2;
        a[0] = bflo(v.x) * rs * ga[0]; a[1] = bfhi(v.x) * rs * ga[1]; a[2] = bflo(v.y) * rs * ga[2]; a[3] = bfhi(v.y) * rs * ga[3];
        b2[0] = bflo(v.z) * rs * gb[0]; b2[1] = bfhi(v.z) * rs * gb[1]; b2[2] = bflo(v.w) * rs * gb[2]; b2[3] = bfhi(v.w) * rs * gb[3];
        *(u32x4*)yp = pg8::pack8(a, b2); }
}
__device__ __forceinline__ void post_rows(const bf16_t* tb, float* h, float cres, const float* gpost, const float* gnext, bf16_t* hb) {
    const int tix = tid_o(); const int lane = tix & 63, gw = bid_o() * (NT / 64) + (tix >> 6), nw = gridDim.x * (NT / 64);
    f32x4 gp[4], gn[4];
#pragma unroll
    for (int j = 0; j < 4; ++j) { gp[j] = *((const f32x4*)gpost + lane + 64 * j); gn[j] = gnext ? *((const f32x4*)gnext + lane + 64 * j) : (f32x4){0.f, 0.f, 0.f, 0.f}; }
    u32x2 tn[4]; f32x4 hn[4];
    if (gw < T) {
#pragma unroll
        for (int j = 0; j < 4; ++j) { tn[j] = *((const u32x2*)(tb + (size_t)gw * D) + lane + 64 * j); hn[j] = *((const f32x4*)(h + (size_t)gw * D) + lane + 64 * j); } }
    for (int row = gw; row < T; row += nw) {
        f32x4 tv[4], hv[4]; float s = 0.f;
#pragma unroll
        for (int j = 0; j < 4; ++j) { tv[j] = (f32x4){bflo(tn[j].x), bfhi(tn[j].x), bflo(tn[j].y), bfhi(tn[j].y)}; hv[j] = hn[j]; }
        if (row + nw < T) {
#pragma unroll
            for (int j = 0; j < 4; ++j) { tn[j] = *((const u32x2*)(tb + (size_t)(row + nw) * D) + lane + 64 * j); hn[j] = *((const f32x4*)(h + (size_t)(row + nw) * D) + lane + 64 * j); } }
#pragma unroll
        for (int j = 0; j < 4; ++j) s += (tv[j][0] * tv[j][0] + tv[j][1] * tv[j][1]) + (tv[j][2] * tv[j][2] + tv[j][3] * tv[j][3]);
        const float rs = __builtin_amdgcn_rsqf(wave_sum(s, lane) * (1.f / D) + EPS) * cres; float s2 = 0.f; f32x4* hp = (f32x4*)(h + (size_t)row * D) + lane;
#pragma unroll
        for (int j = 0; j < 4; ++j) { hv[j] = hv[j] + tv[j] * rs * gp[j]; __builtin_nontemporal_store(hv[j], hp + 64 * j);

            s2 += (hv[j][0] * hv[j][0] + hv[j][1] * hv[j][1]) + (hv[j][2] * hv[j][2] + hv[j][3] * hv[j][3]); }
        if (gnext) { const float r2 = __builtin_amdgcn_rsqf(wave_sum(s2, lane) * (1.f / D) + EPS); u32x2* op = (u32x2*)(hb + (size_t)row * D) + lane;
#pragma unroll
            for (int j = 0; j < 4; ++j) { const f32x4 o = hv[j] * r2 * gn[j]; u32x2 w; w.x = pk2(o[0], o[1]); w.y = pk2(o[2], o[3]); op[64 * j] = w; } }
    }
}
__device__ __forceinline__ void norm_rows(const float* x, int nrows, const float* g, bf16_t* o, float* cp) {
    const int tix = tid_o(); const int lane = tix & 63, gw = bid_o() * (NT / 64) + (tix >> 6), nw = gridDim.x * (NT / 64);
    for (int row = gw; row < nrows; row += nw) {
        const f32x4* xp = (const f32x4*)(x + (size_t)row * D) + lane; f32x4 v[4]; float s = 0.f;
#pragma unroll
        for (int j = 0; j < 4; ++j) { v[j] = xp[64 * j]; s += (v[j][0] * v[j][0] + v[j][1] * v[j][1]) + (v[j][2] * v[j][2] + v[j][3] * v[j][3]); }
        const float rs = __builtin_amdgcn_rsqf(wave_sum(s, lane) * (1.f / D) + EPS); u32x2* op = (u32x2*)(o + (size_t)row * D) + lane;
#pragma unroll
        for (int j = 0; j < 4; ++j) { const f32x4 gn = *((const f32x4*)g + lane + 64 * j); const f32x4 ov = v[j] * rs * gn; u32x2 w; w.x = pk2(ov[0], ov[1]); w.y = pk2(ov[2], ov[3]); op[64 * j] = w;
            if (cp) ((f32x4*)(cp + (size_t)row * D) + lane)[64 * j] = v[j]; }
    }
}
__device__ __forceinline__ int map_col(int kind, int n, int Nsrc) {
    if (kind == 0) return n < Nsrc ? n : -1;
    if (kind == 1) { const int tile = n >> 8, c = n & 255; return c < 128 ? tile * 128 + c : FF + tile * 128 + (c - 128); }
    if (n >= 384) return -1;
    const int h = n / 96, e = n % 96; if (e < 64) return n;
    const int pos = e - 64, a = pos >> 3, nn = (pos >> 2) & 1, jj = pos & 3; return h * 96 + 64 + nn * 16 + 4 * a + jj;
}
__device__ __forceinline__ void convert_w(LAS unsigned char* lds, const float* W, int K, int Nsrc, int Ndst, bf16_t* Wt, int kind, const float* kscale) {
    LAS float* tile = (LAS float*)lds;
    const int tid = tid_o(), tn = tid & 63, tk = tid >> 6;
    const int nkt = K / 64, nitems = (Ndst / 64) * nkt, G = gridDim.x;
    float v[8];
#define CW_LOAD(IT_) do { const int n0_ = ((IT_) / nkt) * 64, k0_ = ((IT_) % nkt) * 64; const int col = map_col(kind, n0_ + tn, Nsrc); \
        _Pragma("unroll") for (int kk = 0; kk < 8; ++kk) { const int kl = tk + 8 * kk; float x = 0.f; \
            if (col >= 0) { x = W[(size_t)(k0_ + kl) * Nsrc + col]; if (kscale) x *= kscale[k0_ + kl]; } v[kk] = x; } } while (0)
    int it = bid_o();
    __syncthreads();
    if (it < nitems) CW_LOAD(it);
    for (; it < nitems; it += G) { const int n0 = (it / nkt) * 64, k0 = (it % nkt) * 64;
        lds_barrier();
#pragma unroll
        for (int kk = 0; kk < 8; ++kk) tile[tn * 65 + tk + 8 * kk] = v[kk];
        lds_barrier();
        if (it + G < nitems) CW_LOAD(it + G);
        const int row = tid >> 3, ck = (tid & 7) * 8; f32x4 a, b;
#pragma unroll
        for (int j = 0; j < 4; ++j) { a[j] = tile[row * 65 + ck + j]; b[j] = tile[row * 65 + ck + 4 + j]; }
        *(u32x4*)(Wt + (size_t)(n0 + row) * K + k0 + ck) = pg8::pack8(a, b); }
#undef CW_LOAD
    __syncthreads();
}

template <int KC>
__device__ __forceinline__ void row_scales(const bf16_t* A, LAS float* rsl, float sc) {
    const int tid = tid_o(), row = tid >> 1, half = tid & 1; const bf16_t* p = A + (size_t)row * LDC + half * (KC / 2); float s = 0.f;
#pragma unroll
    for (int i = 0; i < KC / 16; ++i) { const u32x4 w = *(const u32x4*)(p + i * 8);
        s += bflo(w.x) * bflo(w.x) + bfhi(w.x) * bfhi(w.x) + bflo(w.y) * bflo(w.y) + bfhi(w.y) * bfhi(w.y) + bflo(w.z) * bflo(w.z) + bfhi(w.z) * bfhi(w.z) + bflo(w.w) * bflo(w.w) + bfhi(w.w) * bfhi(w.w); }
    s += dppf<0xB1>(s);
    if (half == 0) rsl[row] = __builtin_amdgcn_rsqf(s * (1.f / KC) + EPS) * sc;
    __syncthreads();
}
struct Args { const float* in[25]; float* out; unsigned char* ws; };
typedef const unsigned char __attribute__((address_space(4))) kconst_t;
__device__ __forceinline__ kconst_t* karg() { kconst_t* p = (kconst_t*)__builtin_amdgcn_kernarg_segment_ptr(); asm volatile("" : "+s"(p)); return p; }
#define IN(i) (((const float* const __attribute__((address_space(4)))*)karg())[i])
#define OUTP (((float* const __attribute__((address_space(4)))*)karg())[25])
#define WSP(type, off) ((type*)((((unsigned char* const __attribute__((address_space(4)))*)karg())[26]) + (off)))
#define WL(L) (WSP(bf16_t, WS_W) + (size_t)(L) * WL_ELEMS)
__device__ __forceinline__ LayerP layer_p(int L) { LayerP P;
    P.ssd_conv_w = IN(7) + (size_t)L * 4 * 768; P.ssd_conv_b = IN(8) + (size_t)L * 768; P.ssd_dt_bias = IN(9) + L * 8; P.ssd_a_log = IN(10) + L * 8;
    P.ssd_d = IN(11) + L * 8; P.ssd_norm_g = IN(12) + (size_t)L * 512; P.gdn_conv_w = IN(17) + (size_t)L * 4 * 768; P.gdn_dt_bias = IN(18) + L * 4;
    P.gdn_a_log = IN(19) + L * 4; P.gdn_norm_g = IN(20) + L * 64; return P; }

template <int PH>
__device__ __forceinline__ void run_phase(LAS unsigned char* lds, const int L, const int f, const int G) {
    constexpr float LOG2E = 1.4426950408889634f;
    if constexpr (PH == 0) {
        for (int l = 0; l < DEPTH; ++l) { bf16_t* wl = WL(l);
            convert_w(lds, IN(4) + ((size_t)l * 2 + 0) * D * 2 * FF, D, 2 * FF, 2 * FF, wl + W_UP0, 1, nullptr);
            convert_w(lds, IN(4) + ((size_t)l * 2 + 1) * D * 2 * FF, D, 2 * FF, 2 * FF, wl + W_UP1, 1, nullptr);
            convert_w(lds, IN(5) + ((size_t)l * 2 + 0) * FF * D, FF, D, D, wl + W_DN0, 0, nullptr);
            convert_w(lds, IN(5) + ((size_t)l * 2 + 1) * FF * D, FF, D, D, wl + W_DN1, 0, nullptr);
            convert_w(lds, IN(6) + (size_t)l * D * 2736, D, 2736, LDC, wl + W_IN, 0, nullptr);
            convert_w(lds, IN(21) + (size_t)l * D * D, D, D, D, wl + W_OUT, 0, nullptr);
            convert_w(lds, IN(22) + (size_t)l * D * D, D, D, D, wl + W_XQ, 0, nullptr);
            convert_w(lds, IN(23) + (size_t)l * D * 2 * D, D, 2 * D, 2 * D, wl + W_XKV, 0, nullptr);
            convert_w(lds, IN(24) + (size_t)l * D * D, D, D, D, wl + W_XO, 0, nullptr);
            convert_w(lds, IN(14) + (size_t)l * 256 * 384, 256, 384, 512, wl + W_UQ, 2, IN(13) + (size_t)l * 256);
            convert_w(lds, IN(16) + (size_t)l * 128 * 512, 128, 512, 512, wl + W_UKV, 0, IN(15) + (size_t)l * 128);
            norm_rows(IN(1), NB * NMEM, IN(3) + ((size_t)l * 9 + 4) * D, WSP(bf16_t, WS_MEMN) + (size_t)l * 2048 * 1024, nullptr);
        }
        norm_rows(IN(0), T, IN(3), WSP(bf16_t, WS_HB), OUTP);
        const int gt = bid_o() * NT + tid_o(), gn = G * NT; const int* positions = (const int*)IN(2);
        float* cosT = WSP(float, WS_COS); float* sinT = WSP(float, WS_SIN);
        for (int i = gt; i < T * 16; i += gn) { const int tok = i >> 4, fi = i & 15;
            const float inv = 1.0f / powf(10000.0f, (float)(2 * fi) / 32.0f); const float ang = (float)positions[tok] * inv;
            double rev = (double)ang * 0.15915494309189535; rev -= rint(rev); const float rv = (float)rev;
            cosT[i] = __builtin_amdgcn_cosf(rv); sinT[i] = __builtin_amdgcn_sinf(rv); }
        if (gt < 1024) WSP(unsigned, WS_CTL)[gt] = 0u;
        if (gt < 4096) WSP(unsigned, WS_XBAR)[gt] = 0u;
    } else if constexpr (PH == 1) {
        const int bx = bid_o(); const int l = bx >> 6; if (l < DEPTH) { pg8::Gemm g{WSP(bf16_t, WS_MEMN) + (size_t)l * 2048 * 1024, WL(l) + W_XKV, D, D, 2048, 2048, D};
            pg8::StaticOrder S; S.init(2048, 2048, 64, bx & 63); pg8::EpiXaKV E{WSP(bf16_t, WS_XK) + (size_t)l * 2048 * 1024, WSP(bf16_t, WS_XVT) + (size_t)l * 1024 * 2048};
            pg8::gemm_phase(lds, g, S, E); }
    } else if constexpr (PH == 2) {
        pg8::Gemm g{WSP(bf16_t, WS_HB), WL(L) + (f ? W_UP1 : W_UP0), D, D, T, 2 * FF, D}; pg8::StaticOrder S; S.init(T, 2 * FF, G, bid_o()); pg8::EpiSwiGLU E{WSP(bf16_t, WS_BIG)}; pg8::gemm_phase(lds, g, S, E);
    } else if constexpr (PH == 3) {
        pg8::Gemm g{WSP(bf16_t, WS_BIG), WL(L) + (f ? W_DN1 : W_DN0), FF, FF, T, D, FF}; pg8::StaticOrder S; S.init(T, D, G, bid_o()); pg8::EpiBf16S E{WSP(bf16_t, WS_TBUF), D, 1.0f}; pg8::gemm_phase(lds, g, S, E);
    } else if constexpr (PH == 4) {
        const float* ng = IN(3) + (size_t)L * 9 * D;
        if (f == 0) post_rows(WSP(bf16_t, WS_TBUF), OUTP, 0.5f, ng + 1 * D, ng + 2 * D, WSP(bf16_t, WS_HB));
        else post_rows(WSP(bf16_t, WS_TBUF), OUTP, 0.5f, ng + 8 * D, (L + 1 < DEPTH) ? ng + 9 * D : nullptr, WSP(bf16_t, WS_HB));
    } else if constexpr (PH == 5) {
        pg8::Gemm g{WSP(bf16_t, WS_HB), WL(L) + W_IN, D, D, T, LDC, D}; pg8::StaticOrder S; S.init(T, LDC, G, bid_o()); pg8::EpiBf16S E{WSP(bf16_t, WS_BIG), LDC, 1.0f}; pg8::gemm_phase(lds, g, S, E);
    } else if constexpr (PH == 6) {
        { int kq = 256; asm volatile("" : "+s"(kq));
            pg8::Gemm g{WSP(bf16_t, WS_BIG) + MLA_CQ, WL(L) + W_UQ, LDC, 256, T, 512, kq}; pg8::StaticOrder S; S.init(T, 512, G, bid_o());
            pg8::Unit u0; LAS float* rsl = (LAS float*)(lds + 131072);
            if (S.next(0, u0)) row_scales<256>(g.A + (size_t)u0.pm * 256 * LDC, rsl, 0.10206207261596577f * LOG2E);
            pg8::EpiMlaQ E{WSP(bf16_t, WS_MQ), rsl}; pg8::gemm_phase(lds, g, S, E); }
    } else if constexpr (PH == 15) {
        { int kq = 128; asm volatile("" : "+s"(kq));
            pg8::Gemm g{WSP(bf16_t, WS_BIG) + MLA_CKV, WL(L) + W_UKV, LDC, 128, T, 512, kq}; pg8::StaticOrder S; S.init(T, 512, G, bid_o());
            pg8::Unit u0; LAS float* rsl = (LAS float*)(lds + 131072);
            if (S.next(0, u0)) row_scales<128>(g.A + (size_t)u0.pm * 256 * LDC, rsl, 1.0f);
            pg8::EpiMlaKV E{WSP(bf16_t, WS_MK), WSP(bf16_t, WS_MVT), rsl}; pg8::gemm_phase(lds, g, S, E); }
    } else if constexpr (PH == 16) {
        { const int gt = bid_o() * NT + tid_o(), gn = G * NT; const bf16_t* big = WSP(bf16_t, WS_BIG); const float* cosT = WSP(float, WS_COS); const float* sinT = WSP(float, WS_SIN); bf16_t* mk = WSP(bf16_t, WS_MK);
            for (int i = gt; i < T * 16; i += gn) { const int tok = i >> 4, f2 = i & 15;
                const float x1 = bf2f(big[(size_t)tok * LDC + MLA_KR + f2]), x2 = bf2f(big[(size_t)tok * LDC + MLA_KR + 16 + f2]);
                const float c = cosT[i], s = sinT[i]; const bf16_t o1 = (bf16_t)f2bf(x1 * c - x2 * s), o2 = (bf16_t)f2bf(x2 * c + x1 * s);
                const int p1 = 8 * (f2 >> 2) + (f2 & 3); bf16_t* kp = mk + (size_t)tok * 384 + 64 + p1;
#pragma unroll
                for (int hh = 0; hh < 4; ++hh) { kp[hh * 96] = o1; kp[hh * 96 + 4] = o2; } } }
        { const LayerP P = layer_p(L); const bf16_t* big = WSP(bf16_t, WS_BIG); bf16_t* gp = WSP(bf16_t, WS_GP); float* gdec = WSP(float, WS_GDEC);
            for (int it = bid_o(); it < 2048; it += G) gdn_prep_item(lds, big, P, gp, gdec, it);
            for (int it = bid_o(); it < 256; it += G) ssd_prep_range(lds, big, P, WSP(bf16_t, WS_Y), WSP(bf16_t, WS_SST), WSP(float, WS_SAC), WSP(bf16_t, WS_CMS), it >> 5, (it >> 2) & 7, (it & 3) * 16, (it & 3) * 16 + 16); }
    } else if constexpr (PH == 7) {
        volatile LAS int* sh_item = (volatile LAS int*)(lds + MISC_OFF);
        unsigned* done = WSP(unsigned, WS_CTL) + 128 + L * 2 + f;
        for (;;) {
            __syncthreads();
            if (tid_o() == 0) *sh_item = (int)atomicAdd(WSP(unsigned, WS_CTL) + L + 8 * f, 1u);
            __syncthreads();
            const int item = *sh_item;
            if (item >= 32 + 64 + 1024 + 1024) break;
            if (item < 32) { const LayerP P = layer_p(L); gdn_scan_item(lds, WSP(bf16_t, WS_BIG), P, WSP(bf16_t, WS_GP), WSP(float, WS_GDEC), WSP(bf16_t, WS_Y), item); }
            else if (item < 96) { ssd_state_scan_item(lds, WSP(bf16_t, WS_SST), WSP(float, WS_SAC), item - 32);
                __syncthreads();
                if (tid_o() == 0) { __builtin_amdgcn_fence(__ATOMIC_RELEASE, "agent"); __hip_atomic_fetch_add(done, 1u, __ATOMIC_RELAXED, __HIP_MEMORY_SCOPE_AGENT); } }
            else if (item < 96 + 1024) { const int a = item - 96, qb = 31 - (a >> 5), b = (a & 31) >> 2, hh = a & 3; const size_t row0 = (size_t)b * SEQ + qb * 128;
                attn_item<96, 64, 2>(lds, WSP(bf16_t, WS_MQ) + row0 * 512 + hh * 96, 512, WSP(bf16_t, WS_MK) + (size_t)b * SEQ * 384 + hh * 96, 384, WSP(bf16_t, WS_MVT) + (size_t)(b * 256 + hh * 64) * 4096, 4096,
                                     WSP(bf16_t, WS_Y) + row0 * 1024 + 512 + hh * 64, 1024, 2 * qb + 2, 2 * qb + 1, WSP(float, WS_COS) + row0 * 16, WSP(float, WS_SIN) + row0 * 16); }
            else {
                if (tid_o() == 0) { while (__hip_atomic_load(done, __ATOMIC_RELAXED, __HIP_MEMORY_SCOPE_AGENT) < 64u) __builtin_amdgcn_s_sleep(2);
                    __builtin_amdgcn_fence(__ATOMIC_ACQUIRE, "agent"); }
                __syncthreads();
                ssd_finish_item(lds, WSP(bf16_t, WS_BIG), IN(12) + (size_t)L * 512, WSP(bf16_t, WS_Y), WSP(bf16_t, WS_SST), WSP(float, WS_SAC), WSP(bf16_t, WS_CMS), item - (96 + 1024)); }
        }
    } else if constexpr (PH == 8) {
        { const float* ngs = IN(12) + (size_t)L * 512; for (int it = bid_o(); it < 1024; it += G) ssd_finish_item(lds, WSP(bf16_t, WS_BIG), ngs, WSP(bf16_t, WS_Y), WSP(bf16_t, WS_SST), WSP(float, WS_SAC), WSP(bf16_t, WS_CMS), it); }
    } else if constexpr (PH == 9) {
        pg8::Gemm g{WSP(bf16_t, WS_Y), WL(L) + W_OUT, D, D, T, D, D}; pg8::StaticOrder S; S.init(T, D, G, bid_o()); pg8::EpiBf16S E{WSP(bf16_t, WS_TBUF), D, 1.0f}; pg8::gemm_phase(lds, g, S, E);
    } else if constexpr (PH == 10) {
        const float* ng = IN(3) + (size_t)L * 9 * D; post_rows(WSP(bf16_t, WS_TBUF), OUTP, 1.0f, ng + 3 * D, ng + 5 * D, WSP(bf16_t, WS_HB));
    } else if constexpr (PH == 11) {
        pg8::Gemm g{WSP(bf16_t, WS_HB), WL(L) + W_XQ, D, D, T, D, D}; pg8::StaticOrder S; S.init(T, D, G, bid_o()); pg8::EpiBf16S E{WSP(bf16_t, WS_BIG), D, 0.0625f * LOG2E}; pg8::gemm_phase(lds, g, S, E);
    } else if constexpr (PH == 12) {
        for (int it = bid_o(); it < 1024; it += G) { const int qb = it >> 5, b = (it & 31) >> 2, hh = it & 3; const size_t row0 = (size_t)b * SEQ + qb * 128;
            attn_item<256, 256, 2>(lds, WSP(bf16_t, WS_BIG) + row0 * 1024 + hh * 256, 1024, WSP(bf16_t, WS_XK) + (size_t)L * 2048 * 1024 + (size_t)b * 256 * 1024 + hh * 256, 1024,
                                WSP(bf16_t, WS_XVT) + (size_t)L * 1024 * 2048 + (size_t)(hh * 256) * 2048 + b * 256, 2048, WSP(bf16_t, WS_Y) + row0 * 1024 + hh * 256, 1024, 4, 4, nullptr, nullptr); }
    } else if constexpr (PH == 13) {
        pg8::Gemm g{WSP(bf16_t, WS_Y), WL(L) + W_XO, D, D, T, D, D}; pg8::StaticOrder S; S.init(T, D, G, bid_o()); pg8::EpiBf16S E{WSP(bf16_t, WS_TBUF), D, 1.0f}; pg8::gemm_phase(lds, g, S, E);
    } else if constexpr (PH == 14) {
        const float* ng = IN(3) + (size_t)L * 9 * D; post_rows(WSP(bf16_t, WS_TBUF), OUTP, 1.0f, ng + 6 * D, ng + 7 * D, WSP(bf16_t, WS_HB));
    }
}

#ifndef MONO
#define MONO 1
#endif
#define XB_TMO      128
#define XB_XCNT(j)  (256  + 64 * (j))
#define XB_XSUB(j)  (1280 + 64 * (j))
#define XB_XGEN(j)  (2304 + 64 * (j))
#define XB_TOP      3328
#define XB_TOPGEN   3392
#define XCD_BAR_WORDS 3456
#define XB_SPIN_CAP (1u << 18)
__device__ __forceinline__ unsigned xb_ld(unsigned* p)              { return __hip_atomic_load(p, __ATOMIC_RELAXED, __HIP_MEMORY_SCOPE_AGENT); }
__device__ __forceinline__ unsigned xb_add(unsigned* p, unsigned v) { return __hip_atomic_fetch_add(p, v, __ATOMIC_RELAXED, __HIP_MEMORY_SCOPE_AGENT); }
__device__ __forceinline__ unsigned xb_xcc_id() { return (unsigned)__builtin_amdgcn_s_getreg((3 << 11) | 20) & 0xFu; }
#define XB_SPIN(cond, bar) do { unsigned _sp = 0; while (cond) { __builtin_amdgcn_s_sleep(1); \
    if ((++_sp & 255u) == 0u) { if (xb_ld(&(bar)[XB_TMO])) break; if (_sp > XB_SPIN_CAP) { atomicAdd(&(bar)[XB_TMO], 1u); break; } } } } while (0)
__device__ __forceinline__ void xcd_barrier_complete(unsigned* bar, unsigned x, unsigned& nloc, unsigned& nx) {
    const unsigned G = gridDim.x;
    unsigned sum, cnt, mine, sp = 0u;
    for (;;) {
        sum = 0u; cnt = 0u; mine = 0u;
#pragma unroll
        for (unsigned j = 0; j < 16; ++j) { const unsigned c = xb_ld(&bar[XB_XCNT(j)]); sum += c; cnt += (c > 0u) ? 1u : 0u; mine = (j == x) ? c : mine; }
        if (sum == G) break;
        __builtin_amdgcn_s_sleep(1);
        if ((++sp & 255u) == 0u) { if (xb_ld(&bar[XB_TMO])) break; if (sp > XB_SPIN_CAP) { atomicAdd(&bar[XB_TMO], 1u); break; } }
    }
    nloc = mine > 0u ? mine : 1u; nx = cnt > 0u ? cnt : 1u;
}
__device__ __forceinline__ void xcd_barrier(unsigned* bar, volatile LAS unsigned* st) {
    asm volatile("s_waitcnt vmcnt(0)" ::: "memory");
    __syncthreads();
    if (tid_o() == 0) {
        const unsigned x = xb_xcc_id();
        __builtin_amdgcn_s_waitcnt(0);
        unsigned nloc = st[0], nx = st[1];
        if (nloc == 0u) { xcd_barrier_complete(bar, x, nloc, nx); st[0] = nloc; st[1] = nx; }
        const unsigned old = xb_add(&bar[XB_XSUB(x)], 1u);
        const unsigned gen = old / nloc;
        if (old + 1u == (gen + 1u) * nloc) {
            __builtin_amdgcn_fence(__ATOMIC_RELEASE, "agent");
            asm volatile("s_waitcnt vmcnt(0)" ::: "memory");
            const unsigned og = xb_add(&bar[XB_TOP], 1u);
            const unsigned tg = og / nx;
            if (og + 1u == (tg + 1u) * nx) xb_add(&bar[XB_TOPGEN], 1u);
            else XB_SPIN(xb_ld(&bar[XB_TOPGEN]) == tg, bar);
            __builtin_amdgcn_fence(__ATOMIC_ACQUIRE, "agent");
            xb_add(&bar[XB_XGEN(x)], 1u);
            asm volatile("s_waitcnt vmcnt(0)" ::: "memory");
        } else {
            XB_SPIN(xb_ld(&bar[XB_XGEN(x)]) == gen, bar);
            __builtin_amdgcn_fence(__ATOMIC_ACQUIRE, "agent");
            asm volatile("s_waitcnt vmcnt(0)" ::: "memory");
        }
    }
    __syncthreads();
}

#if MONO
#ifndef REP_MASK
#define REP_MASK 0u
#endif
#ifndef CG_SYNC
#define CG_SYNC 0
#endif
__device__ __forceinline__ void gsync(unsigned* ctr, unsigned target) {
    __syncthreads();
    if (tid_o() == 0) {
        __builtin_amdgcn_fence(__ATOMIC_RELEASE, "agent");
        __hip_atomic_fetch_add(ctr, 1u, __ATOMIC_RELAXED, __HIP_MEMORY_SCOPE_AGENT);
        while (__hip_atomic_load(ctr, __ATOMIC_RELAXED, __HIP_MEMORY_SCOPE_AGENT) < target) __builtin_amdgcn_s_sleep(1);
        __builtin_amdgcn_fence(__ATOMIC_ACQUIRE, "agent");
    }
    __syncthreads();
}
__global__ void __launch_bounds__(NT, 2) fwd_kernel(Args args) {
    extern __shared__ __attribute__((aligned(16))) unsigned char lds_raw[];
    LAS unsigned char* lds = (LAS unsigned char*)lds_raw;
    cg::grid_group grid = cg::this_grid();
    const int G = gridDim.x;
    unsigned nb = 0;
    if ((threadIdx.x & 63) == 0) *(volatile LAS int*)(unsigned)(MISC_OFF + 64 + hw_slot() * 4) = (int)(threadIdx.x >> 6);
    if (threadIdx.x < 2) *(volatile LAS unsigned*)(unsigned)(MISC_OFF + 8 + threadIdx.x * 4) = 0u;
    __syncthreads();
#if CG_SYNC
#define GSYNC() grid.sync()
#else
#define GSYNC() xcd_barrier(WSP(unsigned, WS_XBAR), (volatile LAS unsigned*)(lds + MISC_OFF + 8))
#endif
#define RUN(P, L, f) do { run_phase<P>(lds, L, f, G); if ((REP_MASK >> P) & 1u) { GSYNC(); run_phase<P>(lds, L, (P == 7) ? 1 : f, G); } } while (0)
    run_phase<0>(lds, 0, 0, G); grid.sync();
    if (tid_o() == 0) (void)xb_add(WSP(unsigned, WS_XBAR) + XB_XCNT(xb_xcc_id()), 1u);
    run_phase<1>(lds, 0, 0, G); GSYNC();
#define LAYER(L) \
        RUN(2, L, 0); GSYNC(); RUN(3, L, 0); GSYNC(); run_phase<4>(lds, L, 0, G); GSYNC(); \
        RUN(5, L, 0); GSYNC(); RUN(6, L, 0); __syncthreads(); RUN(15, L, 0); __syncthreads(); RUN(16, L, 0); GSYNC(); RUN(7, L, 0); GSYNC(); \
        RUN(9, L, 0); GSYNC(); run_phase<10>(lds, L, 0, G); GSYNC(); \
        RUN(11, L, 0); GSYNC(); RUN(12, L, 0); GSYNC(); RUN(13, L, 0); GSYNC(); run_phase<14>(lds, L, 0, G); GSYNC(); \
        RUN(2, L, 1); GSYNC(); RUN(3, L, 1); GSYNC(); run_phase<4>(lds, L, 1, G); GSYNC();
    LAYER(0) LAYER(1) LAYER(2) LAYER(3)
#undef LAYER
#undef RUN
#undef GSYNC
}
#else
template <int PH>
__global__ void __launch_bounds__(NT, 2) phase_kernel(Args args, int L, int f) {
    extern __shared__ __attribute__((aligned(16))) unsigned char lds_raw[];
    if ((threadIdx.x & 63) == 0) *(volatile LAS int*)(unsigned)(MISC_OFF + 64 + hw_slot() * 4) = (int)(threadIdx.x >> 6);
    __syncthreads();
    run_phase<PH>((LAS unsigned char*)lds_raw, L, f, gridDim.x);
}
#endif

#if !MONO
#ifndef PH_MASK
#define PH_MASK 0x1FFFFu
#endif
template <int PH> static void launch_phase(const Args& a, int L, int f, int grid, hipStream_t stream) {
    if (!((PH_MASK >> PH) & 1u)) return;
    static bool attr = false;
    if (!attr) { (void)hipFuncSetAttribute((const void*)phase_kernel<PH>, hipFuncAttributeMaxDynamicSharedMemorySize, LDS_BYTES); attr = true; }
    hipLaunchKernelGGL(phase_kernel<PH>, dim3(grid), dim3(NT), LDS_BYTES, stream, a, L, f);
}
#endif
extern "C" void kernel_launch(void* const* d_in, const int* in_sizes, int n_in, void* d_out, int out_size, void* d_ws, size_t ws_size, hipStream_t stream) {
    static int grid = 0;
    if (grid == 0) {
        if (n_in != 25 || out_size != T * D || ws_size < WS_END) { fprintf(stderr, "kernel_launch: unexpected shapes (n_in %d out %d ws %zu need %zu)\n", n_in, out_size, ws_size, (size_t)WS_END); grid = -1; return; }
        int dev = 0, cus = 0;
        (void)hipGetDevice(&dev); (void)hipDeviceGetAttribute(&cus, hipDeviceAttributeMultiprocessorCount, dev);
#if MONO
        int per_cu = 0;
        if (hipFuncSetAttribute((const void*)fwd_kernel, hipFuncAttributeMaxDynamicSharedMemorySize, LDS_BYTES) != hipSuccess) { fprintf(stderr, "kernel_launch: hipFuncSetAttribute failed\n"); grid = -1; return; }
        if (hipOccupancyMaxActiveBlocksPerMultiprocessor(&per_cu, (const void*)fwd_kernel, NT, LDS_BYTES) != hipSuccess || per_cu < 1) fprintf(stderr, "kernel_launch: occupancy query gave %d\n", per_cu);
        (void)hipGetLastError();
#endif
        grid = cus;
        if (cus != 256) { fprintf(stderr, "kernel_launch: built for 256 CUs, got %d\n", cus); grid = -1; return; }
    }
    if (grid < 0) return;
    Args a{};
    for (int i = 0; i < 25; ++i) a.in[i] = (const float*)d_in[i];
    a.out = (float*)d_out; a.ws = (unsigned char*)d_ws;
#if MONO
    void* kargs[] = {&a};
    hipError_t e = hipLaunchCooperativeKernel((const void*)fwd_kernel, dim3(grid), dim3(NT), kargs, LDS_BYTES, stream);
    if (e != hipSuccess) fprintf(stderr, "cooperative launch failed: %s (grid %d)\n", hipGetErrorString(e), grid);
#else
    launch_phase<0>(a, 0, 0, grid, stream); launch_phase<1>(a, 0, 0, grid, stream);
    for (int L = 0; L < DEPTH; ++L) {
        launch_phase<2>(a, L, 0, grid, stream); launch_phase<3>(a, L, 0, grid, stream); launch_phase<4>(a, L, 0, grid, stream);
        launch_phase<5>(a, L, 0, grid, stream); launch_phase<6>(a, L, 0, grid, stream); launch_phase<15>(a, L, 0, grid, stream); launch_phase<16>(a, L, 0, grid, stream); launch_phase<7>(a, L, 0, grid, stream);
        launch_phase<9>(a, L, 0, grid, stream); launch_phase<10>(a, L, 0, grid, stream);
        launch_phase<11>(a, L, 0, grid, stream); launch_phase<12>(a, L, 0, grid, stream); launch_phase<13>(a, L, 0, grid, stream); launch_phase<14>(a, L, 0, grid, stream);
        launch_phase<2>(a, L, 1, grid, stream); launch_phase<3>(a, L, 1, grid, stream); launch_phase<4>(a, L, 1, grid, stream);
    }
#endif
}
```

```cpp
#include <hip/hip_runtime.h>
#include <hip/hip_cooperative_groups.h>
#include <cstdio>
#include <cstdint>
namespace cg = cooperative_groups;

#define LAS __attribute__((address_space(3)))
typedef unsigned short bf16_t;
typedef short bf16x8 __attribute__((ext_vector_type(8)));
typedef float f32x4 __attribute__((ext_vector_type(4)));
typedef unsigned u32x4 __attribute__((ext_vector_type(4)));
typedef unsigned u32x2 __attribute__((ext_vector_type(2)));

constexpr int NB = 8, SEQ = 4096, T = NB * SEQ, D = 1024, FF = 2816, DEPTH = 4, NMEM = 256;
constexpr int LDC = 2816;
constexpr int SSD_Z = 0, SSD_XBC = 512, SSD_DT = 1280;
constexpr int MLA_CQ = 1288, MLA_CKV = 1544, MLA_KR = 1672;
constexpr int GDN_QKV = 1704, GDN_Z = 2472, GDN_B = 2728, GDN_A = 2732;
constexpr float EPS = 1e-6f;
constexpr int NT = 512;
constexpr int LDS_BYTES = 143360;
constexpr int MISC_OFF = 142848;

constexpr size_t W_UP0 = 0, W_UP1 = 5767168, W_DN0 = 11534336, W_DN1 = 14417920, W_IN = 17301504, W_OUT = 20185088,
                 W_XQ = 21233664, W_XKV = 22282240, W_XO = 24379392, W_UQ = 25427968, W_UKV = 25559040, WL_ELEMS = 25624576;

constexpr size_t WS_CTL = 0;
constexpr size_t WS_COS = 4096;
constexpr size_t WS_SIN = WS_COS + (size_t)T * 16 * 4;
constexpr size_t WS_SSQQ = WS_SIN + (size_t)T * 16 * 4;
constexpr size_t WS_SSQKV = WS_SSQQ + (size_t)T * 4;
constexpr size_t WS_SSDP = WS_SSQKV + (size_t)T * 4;
constexpr size_t WS_GDEC = WS_SSDP + (size_t)T * 16 * 4;
constexpr size_t WS_MEMN = WS_GDEC + 8192;
constexpr size_t WS_XK = WS_MEMN + (size_t)4 * 2048 * 1024 * 2;
constexpr size_t WS_XVT = WS_XK + (size_t)4 * 2048 * 1024 * 2;
constexpr size_t WS_W = WS_XVT + (size_t)4 * 2048 * 1024 * 2;
constexpr size_t WS_TBUF = WS_W + (size_t)DEPTH * WL_ELEMS * 2;
constexpr size_t WS_HB = WS_TBUF + (size_t)T * 1024 * 4;
constexpr size_t WS_BIG = WS_HB + (size_t)T * 1024 * 2;
constexpr size_t WS_Y = WS_BIG + (size_t)T * 2816 * 2;
constexpr size_t WS_CMS = WS_Y + (size_t)T * 1024 * 2;
constexpr size_t WS_SAC = WS_CMS + (size_t)1024 * 4096 * 2;
constexpr size_t WS_XBAR = WS_SAC + (size_t)4096 * 64 * 4;
constexpr size_t WS_END = WS_XBAR + 16384;
constexpr size_t WS_MQ = WS_TBUF;
constexpr size_t WS_MK = WS_MQ + (size_t)T * 512 * 2;
constexpr size_t WS_MVT = WS_MK + (size_t)T * 384 * 2;
constexpr size_t WS_GP = WS_MVT + (size_t)8 * 256 * 4096 * 2;
constexpr size_t WS_SST = WS_GP + (size_t)2048 * 5 * 4096 * 2;
constexpr size_t WS_MIXEND = WS_SST + (size_t)4096 * 4096 * 2;
static_assert(WS_MIXEND <= WS_BIG, "mixer scratch must fit in TBUF+HB");

typedef float f32x2_t __attribute__((ext_vector_type(2)));
typedef __bf16 bf16x2_t __attribute__((ext_vector_type(2)));
__device__ __forceinline__ unsigned pk2(float lo, float hi) { const f32x2_t v = {lo, hi}; const bf16x2_t b = __builtin_convertvector(v, bf16x2_t); return __builtin_bit_cast(unsigned, b); }
__device__ __forceinline__ unsigned f2bf(float f) { return pk2(f, f) & 0xffffu; }
__device__ __forceinline__ float bf2f(unsigned b) { return __builtin_bit_cast(float, (b & 0xffffu) << 16); }
__device__ __forceinline__ float bflo(unsigned w) { return __builtin_bit_cast(float, w << 16); }
__device__ __forceinline__ float bfhi(unsigned w) { return __builtin_bit_cast(float, w & 0xffff0000u); }
__device__ __forceinline__ float silu_f(float x) { return x * __builtin_amdgcn_rcpf(1.f + __expf(-x)); }
__device__ __forceinline__ float softplus_f(float x) { return x > 20.f ? x : __logf(1.f + __expf(x)); }
__device__ __forceinline__ unsigned hw_slot() { return (unsigned)__builtin_amdgcn_s_getreg((5 << 11) | 4) & 63u; }
__device__ __forceinline__ int tid_o() {
    const int wv = __builtin_amdgcn_readfirstlane(*(volatile LAS int*)(unsigned)(MISC_OFF + 64 + hw_slot() * 4));
    int ln; asm volatile("v_mbcnt_lo_u32_b32 %0, -1, 0\n\tv_mbcnt_hi_u32_b32 %0, -1, %0" : "=v"(ln));
    return wv * 64 + ln; }
__device__ __forceinline__ int bid_o() { int b = blockIdx.x; asm volatile("" : "+s"(b)); return b; }
#define MFMA16(a, b, c) __builtin_amdgcn_mfma_f32_16x16x32_bf16(a, b, c, 0, 0, 0)

namespace pg8 {
constexpr int BM = 256, BK = 64, HALF = 128, HTB = HALF * BK * 2, STAGE_BYTES = 8 * HTB, NXCD = 8, WGM = 4;
__device__ __forceinline__ int lds_byte(int r, int c) { const int st = (r >> 4) * 2 + (c >> 5), rr = r & 15, cc = c & 31, ob = rr * 64 + cc * 2; return st * 1024 + (ob ^ (((ob >> 9) & 1) << 5)); }
__device__ __forceinline__ void stage_rc(int b, int& R, int& C) { const int st = b / 1024, sb = b % 1024, swz = sb ^ (((sb >> 9) & 1) << 5); R = (st >> 1) * 16 + swz / 64; C = (st & 1) * 32 + (swz % 64) / 2; }
__device__ __forceinline__ int perm32(int rho) { const int n = rho >> 4, i = rho & 15; return 8 * (i >> 2) + 4 * n + (i & 3); }
struct Unit { int pm, pn; };
struct Gemm { const bf16_t* A; const bf16_t* Bt; int lda, ldb, M, N, K; };
struct StaticOrder {
    int nM, nN, nwg, G, c;
    __device__ void init(int M, int N, int G_, int c_) { nM = M / BM; nN = N / BM; nwg = nM * nN; G = G_; c = c_; }
    __device__ bool next(int i, Unit& u) const {
        const long L = (long)i * G + c; if (L >= nwg) return false;
        int wgid = (int)L; { const int q = nwg / NXCD, r = nwg % NXCD, xcd = wgid % NXCD, off = wgid / NXCD; wgid = (xcd < r ? xcd * (q + 1) : r * (q + 1) + (xcd - r) * q) + off; }
        const int nig = WGM * nN, gid = wgid / nig, fm = gid * WGM, gsz = (nM - fm) < WGM ? (nM - fm) : WGM;
        u.pm = fm + ((wgid % nig) % gsz); u.pn = (wgid % nig) / gsz; return true;
    }
};
template <class Epi>
__device__ __forceinline__ void gemm_phase(LAS unsigned char* lds, const Gemm g, const StaticOrder& S, const Epi& E) {
    const int tid = tid_o(), wid = __builtin_amdgcn_readfirstlane(tid >> 6), lane = tid & 63, wr = wid >> 2, wc = wid & 3, fr = lane & 15, fq = lane >> 4;
    const int K = g.K, nt = K / BK;
    unsigned voffA[2], voffB[2];
#pragma unroll
    for (int i = 0; i < 2; ++i) { int R, C; stage_rc(tid * 16 + i * 8192, R, C); const int Rb = (R & ~31) + perm32(R & 31);
        voffA[i] = (unsigned)(R * g.lda + C) * 2u; voffB[i] = (unsigned)(Rb * g.ldb + C) * 2u; }
    const size_t kstep = (size_t)(BK * 2);
    const size_t hA = (size_t)HALF * g.lda * 2, hB = (size_t)HALF * g.ldb * 2;
    const size_t tA = 2 * hA, tB = 2 * hB;
    const unsigned ldsw = (unsigned)wid * 1024u;
    const int aoff = lds_byte(wr * 64 + fr, fq * 8), boff = lds_byte(wc * 32 + fr, fq * 8);
#define PG8_SA(b, h) (((b) * 2 + (h)) * HTB)
#define PG8_SB(b, h) ((4 + (b) * 2 + (h)) * HTB)
#define PG8_STAGE(bufoff, gbase, voff) do { _Pragma("unroll") for (int _i = 0; _i < 2; ++_i) \
        __builtin_amdgcn_global_load_lds((const unsigned*)((const char*)(gbase) + (voff)[_i]), (LAS unsigned*)(lds + (bufoff) + ldsw + _i * 8192), 16, 0, 0); } while (0)
#define PG8_LDA(dst, b, h) do { _Pragma("unroll") for (int m = 0; m < 4; ++m) _Pragma("unroll") for (int k = 0; k < 2; ++k) dst[m][k] = *(const LAS bf16x8*)(lds + PG8_SA(b, h) + aoff + m * 2048 + k * 1024); } while (0)
#define PG8_LDB(dst, b, h) do { _Pragma("unroll") for (int n = 0; n < 2; ++n) _Pragma("unroll") for (int k = 0; k < 2; ++k) dst[n][k] = *(const LAS bf16x8*)(lds + PG8_SB(b, h) + boff + n * 2048 + k * 1024); } while (0)
#define PG8_MMA(ai, bj, At, Bt) do { __builtin_amdgcn_s_setprio(1); _Pragma("unroll") for (int m = 0; m < 4; ++m) _Pragma("unroll") for (int n = 0; n < 2; ++n) _Pragma("unroll") for (int k = 0; k < 2; ++k) \
        acc[ai][bj][m][n] = __builtin_amdgcn_mfma_f32_16x16x32_bf16(Bt[n][k], At[m][k], acc[ai][bj][m][n], 0, 0, 0); __builtin_amdgcn_s_setprio(0); } while (0)
#define PG8_WAIT_V(n) asm volatile("s_waitcnt vmcnt(" #n ")" ::: "memory")
#define PG8_WAIT_L(n) asm volatile("s_waitcnt lgkmcnt(" #n ")" ::: "memory")
#define PG8_BAR __builtin_amdgcn_s_barrier()
#define PG8_SCHED __builtin_amdgcn_sched_barrier(0)
    Unit cur, nxt; int ui = 0;
    if (!S.next(0, cur)) return;
    f32x4 acc[2][2][4][2];
#pragma unroll
    for (int a = 0; a < 2; ++a)
#pragma unroll
        for (int b = 0; b < 2; ++b)
#pragma unroll
            for (int m = 0; m < 4; ++m)
#pragma unroll
                for (int n = 0; n < 2; ++n) acc[a][b][m][n] = (f32x4){0.f, 0.f, 0.f, 0.f};
    bf16x8 At[4][2], B0[2][2], B1[2][2];
    const char* cA = (const char*)g.A + (size_t)cur.pm * tA; const char* cB = (const char*)g.Bt + (size_t)cur.pn * tB;
    PG8_STAGE(PG8_SB(0, 0), cB, voffB); PG8_STAGE(PG8_SB(0, 1), cB + hB, voffB); PG8_STAGE(PG8_SA(0, 0), cA, voffA); PG8_STAGE(PG8_SA(0, 1), cA + hA, voffA);
    if (wr == 1) PG8_BAR;
    PG8_WAIT_V(2); PG8_BAR;
    PG8_STAGE(PG8_SB(1, 0), cB + kstep, voffB); PG8_STAGE(PG8_SA(1, 0), cA + kstep, voffA); PG8_STAGE(PG8_SB(1, 1), cB + hB + kstep, voffB);
    PG8_WAIT_V(6); PG8_BAR;
    for (;;) {
        const bool has_next = S.next(ui + 1, nxt);
        const char* nA = has_next ? (const char*)g.A + (size_t)nxt.pm * tA : cA; const char* nB = has_next ? (const char*)g.Bt + (size_t)nxt.pn * tB : cB;
        for (int t = 0; t < nt; t += 2) {
            const bool last = (t == nt - 2);
            const char* a1 = cA + (size_t)(t + 1) * kstep;
            const char* a2 = last ? nA : cA + (size_t)(t + 2) * kstep; const char* b2 = last ? nB : cB + (size_t)(t + 2) * kstep;
            const char* a3 = a2 + kstep; const char* b3 = b2 + kstep;
            PG8_LDB(B0, 0, 0); PG8_LDB(B1, 0, 1); PG8_SCHED; PG8_LDA(At, 0, 0); PG8_STAGE(PG8_SA(1, 1), a1 + hA, voffA);
            PG8_WAIT_V(8); PG8_WAIT_L(0); PG8_BAR; PG8_MMA(0, 0, At, B0); PG8_MMA(0, 1, At, B1); PG8_BAR; PG8_SCHED;
            PG8_LDA(At, 0, 1); PG8_STAGE(PG8_SB(0, 0), b2, voffB); PG8_STAGE(PG8_SB(0, 1), b2 + hB, voffB); PG8_STAGE(PG8_SA(0, 0), a2, voffA);
            PG8_WAIT_V(8); PG8_WAIT_L(0); PG8_BAR; PG8_MMA(1, 0, At, B0); PG8_MMA(1, 1, At, B1); PG8_BAR; PG8_SCHED;
            PG8_LDB(B0, 1, 0); PG8_LDB(B1, 1, 1); PG8_SCHED; PG8_LDA(At, 1, 0); PG8_STAGE(PG8_SA(0, 1), a2 + hA, voffA);
            PG8_WAIT_V(8); PG8_WAIT_L(0); PG8_BAR; PG8_MMA(0, 0, At, B0); PG8_MMA(0, 1, At, B1); PG8_BAR; PG8_SCHED;
            PG8_LDA(At, 1, 1); PG8_STAGE(PG8_SB(1, 0), b3, voffB); PG8_STAGE(PG8_SB(1, 1), b3 + hB, voffB); PG8_STAGE(PG8_SA(1, 0), a3, voffA);
            PG8_WAIT_V(8); PG8_WAIT_L(0); PG8_BAR; PG8_MMA(1, 0, At, B0); PG8_MMA(1, 1, At, B1); PG8_BAR; PG8_SCHED;
        }
        if (wr == 0) PG8_BAR;
        { int fr_e = fr, fq_e = fq; asm volatile("" : "+v"(fr_e), "+v"(fq_e)); E(acc, cur, wr, wc, fr_e, fq_e); }
        if (!has_next) break;
#pragma unroll
        for (int a = 0; a < 2; ++a)
#pragma unroll
            for (int b = 0; b < 2; ++b)
#pragma unroll
                for (int m = 0; m < 4; ++m)
#pragma unroll
                    for (int n = 0; n < 2; ++n) acc[a][b][m][n] = (f32x4){0.f, 0.f, 0.f, 0.f};
        cur = nxt; cA = nA; cB = nB; ++ui;
        if (wr == 1) PG8_BAR;
    }
    PG8_WAIT_V(0);
    PG8_BAR;
#undef PG8_SA
#undef PG8_SB
#undef PG8_STAGE
#undef PG8_LDA
#undef PG8_LDB
#undef PG8_MMA
#undef PG8_WAIT_V
#undef PG8_WAIT_L
#undef PG8_BAR
#undef PG8_SCHED
}
typedef const f32x4 (&AccRef)[2][2][4][2];
__device__ __forceinline__ u32x4 pack8(f32x4 a, f32x4 b) { u32x4 w; w.x = pk2(a[0], a[1]); w.y = pk2(a[2], a[3]); w.z = pk2(b[0], b[1]); w.w = pk2(b[2], b[3]); return w; }

struct EpiSwiGLU { bf16_t* O;
    __device__ __forceinline__ void operator()(AccRef acc, const Unit& u, int wr, int wc, int fr, int fq) const {
        const int row0 = u.pm * BM + wr * 64 + fr, col0 = u.pn * 128 + wc * 32 + fq * 8;
#pragma unroll
        for (int ai = 0; ai < 2; ++ai)
#pragma unroll
            for (int m = 0; m < 4; ++m) { const int row = row0 + ai * HALF + m * 16; f32x4 v0, v1;
#pragma unroll
                for (int j = 0; j < 4; ++j) { v0[j] = silu_f(acc[ai][0][m][0][j]) * acc[ai][1][m][0][j]; v1[j] = silu_f(acc[ai][0][m][1][j]) * acc[ai][1][m][1][j]; }
                *(u32x4*)(O + (size_t)row * FF + col0) = pack8(v0, v1); }
    }
};
struct EpiF32 { float* O; int ldc;
    __device__ __forceinline__ void operator()(AccRef acc, const Unit& u, int wr, int wc, int fr, int fq) const {
        const int row0 = u.pm * BM + wr * 64 + fr, col0 = u.pn * BM + wc * 32 + fq * 8;
#pragma unroll
        for (int ai = 0; ai < 2; ++ai)
#pragma unroll
            for (int m = 0; m < 4; ++m) { float* rp = O + (size_t)(row0 + ai * HALF + m * 16) * ldc + col0;
#pragma unroll
                for (int bj = 0; bj < 2; ++bj) { *(f32x4*)(rp + bj * HALF) = acc[ai][bj][m][0]; *(f32x4*)(rp + bj * HALF + 4) = acc[ai][bj][m][1]; } }
    }
};
struct EpiBf16S { bf16_t* O; int ldc; float sc;
    __device__ __forceinline__ void operator()(AccRef acc, const Unit& u, int wr, int wc, int fr, int fq) const {
        const int row0 = u.pm * BM + wr * 64 + fr, col0 = u.pn * BM + wc * 32 + fq * 8;
#pragma unroll
        for (int ai = 0; ai < 2; ++ai)
#pragma unroll
            for (int m = 0; m < 4; ++m) { bf16_t* rp = O + (size_t)(row0 + ai * HALF + m * 16) * ldc + col0;
#pragma unroll
                for (int bj = 0; bj < 2; ++bj) *(u32x4*)(rp + bj * HALF) = pack8(acc[ai][bj][m][0] * sc, acc[ai][bj][m][1] * sc); }
    }
};
struct EpiCols { bf16_t* O; float* ssqq; float* ssqkv;
    __device__ __forceinline__ void operator()(AccRef acc, const Unit& u, int wr, int wc, int fr, int fq) const {
        const int row0 = u.pm * BM + wr * 64 + fr, col0 = u.pn * BM + wc * 32 + fq * 8;
#pragma unroll
        for (int ai = 0; ai < 2; ++ai)
#pragma unroll
            for (int m = 0; m < 4; ++m) { const int row = row0 + ai * HALF + m * 16; bf16_t* rp = O + (size_t)row * LDC + col0;
#pragma unroll
                for (int bj = 0; bj < 2; ++bj) { const f32x4 v0 = acc[ai][bj][m][0], v1 = acc[ai][bj][m][1];
                    *(u32x4*)(rp + bj * HALF) = pack8(v0, v1);
                    const int c = col0 + bj * HALF;
                    if (c >= MLA_CQ && c < MLA_KR) { float s = 0.f;
#pragma unroll
                        for (int j = 0; j < 4; ++j) s += v0[j] * v0[j] + v1[j] * v1[j];
                        __hip_atomic_fetch_add((c < MLA_CKV ? ssqq : ssqkv) + row, s, __ATOMIC_RELAXED, __HIP_MEMORY_SCOPE_AGENT); } } }
    }
};
struct EpiMlaQ { bf16_t* O; const LAS float* rsl;
    __device__ __forceinline__ void operator()(AccRef acc, const Unit& u, int wr, int wc, int fr, int fq) const {
        const int row0 = u.pm * BM + wr * 64 + fr, col0 = u.pn * BM + wc * 32 + fq * 8;
#pragma unroll
        for (int ai = 0; ai < 2; ++ai)
#pragma unroll
            for (int m = 0; m < 4; ++m) { const int row = row0 + ai * HALF + m * 16; const float rs = rsl[wr * 64 + fr + ai * HALF + m * 16]; bf16_t* rp = O + (size_t)row * 512 + col0;
#pragma unroll
                for (int bj = 0; bj < 2; ++bj) *(u32x4*)(rp + bj * HALF) = pack8(acc[ai][bj][m][0] * rs, acc[ai][bj][m][1] * rs); }
    }
};
struct EpiMlaKV { bf16_t* Kb; bf16_t* VT; const LAS float* rsl;
    __device__ __forceinline__ void operator()(AccRef acc, const Unit& u, int wr, int wc, int fr, int fq) const {
        const int row0 = u.pm * BM + wr * 64 + fr;
#pragma unroll
        for (int ai = 0; ai < 2; ++ai)
#pragma unroll
            for (int m = 0; m < 4; ++m) { const int row = row0 + ai * HALF + m * 16; const float rs = rsl[wr * 64 + fr + ai * HALF + m * 16];
                const int b = row >> 12, s = row & 4095;
#pragma unroll
                for (int bj = 0; bj < 2; ++bj) { const int cb = u.pn * BM + bj * HALF + wc * 32; const int h = cb >> 7, e0 = cb & 127;
                    const f32x4 v0 = acc[ai][bj][m][0] * rs, v1 = acc[ai][bj][m][1] * rs;
                    if (e0 < 64) *(u32x4*)(Kb + (size_t)row * 384 + h * 96 + e0 + fq * 8) = pack8(v0, v1);
                    else { bf16_t* vp = VT + ((size_t)(b * 256 + h * 64 + e0 - 64 + fq * 8) * 4096) + s;
#pragma unroll
                        for (int j = 0; j < 4; ++j) { vp[(size_t)j * 4096] = (bf16_t)f2bf(v0[j]); vp[(size_t)(4 + j) * 4096] = (bf16_t)f2bf(v1[j]); } } } }
    }
};
struct EpiXaKV { bf16_t* Kb; bf16_t* VT;
    __device__ __forceinline__ void operator()(AccRef acc, const Unit& u, int wr, int wc, int fr, int fq) const {
        const int row0 = u.pm * BM + wr * 64 + fr, col0 = u.pn * BM + wc * 32 + fq * 8;
#pragma unroll
        for (int ai = 0; ai < 2; ++ai)
#pragma unroll
            for (int m = 0; m < 4; ++m) { const int row = row0 + ai * HALF + m * 16;
#pragma unroll
                for (int bj = 0; bj < 2; ++bj) { const int c = col0 + bj * HALF; const f32x4 v0 = acc[ai][bj][m][0], v1 = acc[ai][bj][m][1];
                    if (c < 1024) *(u32x4*)(Kb + (size_t)row * 1024 + c) = pack8(v0, v1);
                    else { bf16_t* vp = VT + (size_t)(c - 1024) * 2048 + row;
#pragma unroll
                        for (int j = 0; j < 4; ++j) { vp[(size_t)j * 2048] = (bf16_t)f2bf(v0[j]); vp[(size_t)(4 + j) * 2048] = (bf16_t)f2bf(v1[j]); } } } }
    }
};
}

__device__ __forceinline__ void lds_barrier() { asm volatile("s_waitcnt lgkmcnt(0)" ::: "memory"); __builtin_amdgcn_s_barrier(); asm volatile("" ::: "memory"); }
template <int CTRL> __device__ __forceinline__ float dppf(float v) { return __builtin_bit_cast(float, __builtin_amdgcn_update_dpp(0, __builtin_bit_cast(int, v), CTRL, 0xF, 0xF, true)); }
__device__ __forceinline__ float row16_max(float v) { v = fmaxf(v, dppf<0xB1>(v)); v = fmaxf(v, dppf<0x4E>(v)); v = fmaxf(v, dppf<0x141>(v)); v = fmaxf(v, dppf<0x140>(v)); return v; }
__device__ __forceinline__ float row16_sum(float v) { v += dppf<0xB1>(v); v += dppf<0x4E>(v); v += dppf<0x141>(v); v += dppf<0x140>(v); return v; }
__device__ __forceinline__ float bperm_f(float v, int srclane) { return __builtin_bit_cast(float, __builtin_amdgcn_ds_bpermute(srclane << 2, __builtin_bit_cast(int, v))); }
__device__ __forceinline__ float wave_sum(float v, int lane) { v = row16_sum(v); v += bperm_f(v, lane ^ 16); v += bperm_f(v, lane ^ 32); return v; }
__device__ __forceinline__ float row8_sum(float v) { v += dppf<0xB1>(v); v += dppf<0x4E>(v); v += dppf<0x141>(v); return v; }
__device__ __forceinline__ bf16x8 lds_frag(const LAS unsigned char* p) { return *(const LAS bf16x8*)p; }

template <int DQK, int DV, int NST>
__device__ __forceinline__ void attn_item(LAS unsigned char* lds, const bf16_t* Q, int ldq, const bf16_t* Kp, int ldk, const bf16_t* VT, int ldv,
                                          bf16_t* Y, int ldy, int nkt, int nkt_lo, const float* cs, const float* sn) {
    constexpr int KS = DQK / 32, KST = DQK + 8, NVT = DV / 16;
    constexpr int KT_BYTES = 64 * KST * 2, VT_BYTES = DV * 72 * 2, ST_BYTES = KT_BYTES + VT_BYTES;
    constexpr int KPC = 64 * DQK / 8, VPC = DV * 8;
    constexpr int KPT = (KPC + NT - 1) / NT, VPT = (VPC + NT - 1) / NT;
    static_assert(NST * ST_BYTES <= MISC_OFF, "attention LDS");
    const int tid = tid_o(), wid = tid >> 6, lane = tid & 63, r = lane & 15, q = lane >> 4;
    bf16x8 qf[KS];
#pragma unroll
    for (int ks = 0; ks < KS; ++ks) qf[ks] = *(const bf16x8*)(Q + (size_t)(wid * 16 + r) * ldq + ks * 32 + q * 8);
    if constexpr (DQK == 96) {
        const f32x4 c4 = *(const f32x4*)(cs + (size_t)(wid * 16 + r) * 16 + q * 4), s4 = *(const f32x4*)(sn + (size_t)(wid * 16 + r) * 16 + q * 4);
        const u32x4 w = __builtin_bit_cast(u32x4, qf[2]);
        const f32x4 x1 = {bflo(w.x), bfhi(w.x), bflo(w.y), bfhi(w.y)}, x2 = {bflo(w.z), bfhi(w.z), bflo(w.w), bfhi(w.w)};
        qf[2] = __builtin_bit_cast(bf16x8, pg8::pack8(x1 * c4 - x2 * s4, x2 * c4 + x1 * s4)); }
    f32x4 o[NVT];
#pragma unroll
    for (int i = 0; i < NVT; ++i) o[i] = (f32x4){0.f, 0.f, 0.f, 0.f};
    float mrow = -1e30f, lrow = 0.f;
    const int my_nkt = (wid < 4) ? nkt_lo : nkt;
    u32x4 kreg[KPT], vreg[VPT];
#define ATT_LOAD(KT_) do { const bf16_t* Kn = Kp + (size_t)(KT_) * 64 * ldk; const bf16_t* Vn = VT + (size_t)(KT_) * 64; \
        _Pragma("unroll") for (int i = 0; i < KPT; ++i) { const int p = tid + i * NT; if (p < KPC) { const int row = p / (DQK / 8), pc = p % (DQK / 8); kreg[i] = *(const u32x4*)(Kn + (size_t)row * ldk + pc * 8); } } \
        _Pragma("unroll") for (int i = 0; i < VPT; ++i) { const int p = tid + i * NT; if (p < VPC) { const int row = p >> 3, pc = p & 7; vreg[i] = *(const u32x4*)(Vn + (size_t)row * ldv + pc * 8); } } } while (0)
#define ATT_STORE(STG_) do { LAS unsigned char* kd = lds + (STG_) * ST_BYTES; LAS unsigned char* vd = kd + KT_BYTES; \
        _Pragma("unroll") for (int i = 0; i < KPT; ++i) { const int p = tid + i * NT; if (p < KPC) { const int row = p / (DQK / 8), pc = p % (DQK / 8); *(LAS u32x4*)(kd + (row * KST + pc * 8) * 2) = kreg[i]; } } \
        _Pragma("unroll") for (int i = 0; i < VPT; ++i) { const int p = tid + i * NT; if (p < VPC) { const int row = p >> 3, pc = p & 7; *(LAS u32x4*)(vd + (row * 72 + pc * 8) * 2) = vreg[i]; } } } while (0)
    __syncthreads();
    ATT_LOAD(0); ATT_STORE(0);
    __syncthreads();
    for (int kt = 0; kt < nkt; ++kt) {
        const int stg = (NST == 2) ? (kt & 1) : 0;
        LAS unsigned char* kt_l = lds + stg * ST_BYTES; LAS unsigned char* vt_l = kt_l + KT_BYTES;
        if (kt + 1 < nkt) ATT_LOAD(kt + 1);
        if (kt < my_nkt) {
            f32x4 st[4];
#pragma unroll
            for (int nt = 0; nt < 4; ++nt) { st[nt] = (f32x4){0.f, 0.f, 0.f, 0.f};
#pragma unroll
                for (int ks = 0; ks < KS; ++ks) st[nt] = MFMA16(lds_frag(kt_l + ((nt * 16 + r) * KST + ks * 32 + q * 8) * 2), qf[ks], st[nt]); }
            float mx = fmaxf(fmaxf(fmaxf(st[0][0], st[0][1]), fmaxf(st[0][2], st[0][3])), fmaxf(fmaxf(st[1][0], st[1][1]), fmaxf(st[1][2], st[1][3])));
            mx = fmaxf(mx, fmaxf(fmaxf(fmaxf(st[2][0], st[2][1]), fmaxf(st[2][2], st[2][3])), fmaxf(fmaxf(st[3][0], st[3][1]), fmaxf(st[3][2], st[3][3]))));
            mx = fmaxf(mx, bperm_f(mx, lane ^ 16)); mx = fmaxf(mx, bperm_f(mx, lane ^ 32));
            const float mn = fmaxf(mrow, mx), alpha = __builtin_amdgcn_exp2f(mrow - mn); mrow = mn; float rs = 0.f;
#pragma unroll
            for (int nt = 0; nt < 4; ++nt)
#pragma unroll
                for (int i = 0; i < 4; ++i) { const float p = __builtin_amdgcn_exp2f(st[nt][i] - mn); st[nt][i] = p; rs += p; }
            lrow = lrow * alpha + rs;
            bf16x8 pf[2];
#pragma unroll
            for (int ks2 = 0; ks2 < 2; ++ks2) pf[ks2] = __builtin_bit_cast(bf16x8, pg8::pack8(st[2 * ks2], st[2 * ks2 + 1]));
#pragma unroll
            for (int d = 0; d < NVT; ++d) { o[d] = o[d] * alpha;
#pragma unroll
                for (int ks2 = 0; ks2 < 2; ++ks2) { const LAS unsigned char* vp = vt_l + ((d * 16 + r) * 72 + ks2 * 32 + q * 4) * 2;
                    const u32x2 v0 = *(const LAS u32x2*)vp, v1 = *(const LAS u32x2*)(vp + 32);
                    const u32x4 vv = {v0.x, v0.y, v1.x, v1.y};
                    o[d] = MFMA16(__builtin_bit_cast(bf16x8, vv), pf[ks2], o[d]); } }
        }
        if (kt + 1 < nkt) {
            if constexpr (NST == 1) lds_barrier();
            ATT_STORE((NST == 2) ? ((kt + 1) & 1) : 0);
        }
        lds_barrier();
    }
#undef ATT_LOAD
#undef ATT_STORE
    { float ls = lrow; ls += bperm_f(ls, lane ^ 16); ls += bperm_f(ls, lane ^ 32); const float inv = 1.f / ls; bf16_t* yp = Y + (size_t)(wid * 16 + r) * ldy + q * 4;
#pragma unroll
        for (int d = 0; d < NVT; ++d) { u32x2 w; w.x = pk2(o[d][0] * inv, o[d][1] * inv); w.y = pk2(o[d][2] * inv, o[d][3] * inv); *(u32x2*)(yp + d * 16) = w; } }
}

struct LayerP {
    const float* ssd_conv_w; const float* ssd_conv_b; const float* ssd_dt_bias; const float* ssd_a_log; const float* ssd_d; const float* ssd_norm_g;
    const float* gdn_conv_w; const float* gdn_dt_bias; const float* gdn_a_log; const float* gdn_norm_g;
};
__device__ __forceinline__ void gdn_prep_item(LAS unsigned char* lds, const bf16_t* cols, const LayerP& P, bf16_t* GP, float* gdec, int item) {
    const int tid = tid_o(), wid = tid >> 6, lane = tid & 63, r = lane & 15, q = lane >> 4;
    const int h = item & 3, c = (item >> 2) & 63, b = item >> 8;
    LAS bf16_t* RAW = (LAS bf16_t*)lds;
    LAS float* QF = (LAS float*)(lds + 25856);
    LAS float* KF = QF + 64 * 65; LAS float* VF = KF + 64 * 65;
    LAS unsigned char* QB = lds + 75776; LAS unsigned char* KB = QB + 9216; LAS unsigned char* KBB = KB + 9216;
    LAS float* MM = (LAS float*)(lds + 103424);
    LAS float* BETA = (LAS float*)(lds + 120832); LAS float* GC = BETA + 64;
    const size_t tok0 = (size_t)b * SEQ + (size_t)c * 64;
    bf16_t* gp = GP + (size_t)item * (5 * 4096);
    bf16_t* gU = gp; bf16_t* gW = gp + 4096; bf16_t* gQK = gp + 8192; bf16_t* gQD = gp + 12288; bf16_t* gKDT = gp + 16384;
    lds_barrier();
    for (int i = tid; i < 67 * 24; i += NT) { const int rr = i / 24, rem = i % 24, p = rem >> 3, pc = rem & 7; const int t = c * 64 - 3 + rr;
        u32x4 v = (u32x4){0u, 0u, 0u, 0u};
        if (t >= 0) v = *(const u32x4*)(cols + ((size_t)b * SEQ + t) * LDC + GDN_QKV + p * 256 + h * 64 + pc * 8);
        *(LAS u32x4*)(RAW + rr * 192 + p * 64 + pc * 8) = v; }
    if (wid == 7) { const size_t tok = tok0 + lane;
        const float braw = bf2f(cols[tok * LDC + GDN_B + h]), araw = bf2f(cols[tok * LDC + GDN_A + h]);
        const float beta = __builtin_amdgcn_rcpf(1.f + __expf(-braw));
        float g = -__expf(P.gdn_a_log[h]) * softplus_f(araw + P.gdn_dt_bias[h]);
#pragma unroll
        for (int o = 1; o < 64; o <<= 1) { const float t = bperm_f(g, lane - o); if (lane >= o) g += t; }
        BETA[lane] = beta; GC[lane] = g; }
    lds_barrier();
    if (tid < 384) { const int ch = tid % 192, l0 = tid / 192, p = ch >> 6, d = ch & 63; const int C = p * 256 + h * 64 + d;
        const float w0 = P.gdn_conv_w[C], w1 = P.gdn_conv_w[768 + C], w2 = P.gdn_conv_w[1536 + C], w3 = P.gdn_conv_w[2304 + C];
        LAS float* F = QF + p * (64 * 65);
        const int lb = l0 * 32; float x0 = bf2f(RAW[lb * 192 + ch]), x1 = bf2f(RAW[(lb + 1) * 192 + ch]), x2 = bf2f(RAW[(lb + 2) * 192 + ch]);
#pragma unroll 4
        for (int j = 0; j < 32; ++j) { const int l = lb + j; const float x3 = bf2f(RAW[(l + 3) * 192 + ch]);
            F[l * 65 + d] = silu_f(w0 * x0 + w1 * x1 + w2 * x2 + w3 * x3); x0 = x1; x1 = x2; x2 = x3; } }
    lds_barrier();
    { const int row = tid >> 2, sub = tid & 3, which = row >> 6, l = row & 63; LAS float* F = (which ? KF : QF) + l * 65 + sub * 16; float s = 0.f;
#pragma unroll
        for (int j = 0; j < 16; ++j) s += F[j] * F[j];
        s += dppf<0xB1>(s); s += dppf<0x4E>(s);
        const float rn = __builtin_amdgcn_rsqf(s + EPS) * (which ? 1.f : 0.125f);
#pragma unroll
        for (int j = 0; j < 16; ++j) F[j] *= rn; }
    lds_barrier();
    { const int l = tid >> 3, d0 = (tid & 7) * 8; const float beta = BETA[l], eg = __expf(GC[l]);
        f32x4 qa, qb, ka, kb;
#pragma unroll
        for (int j = 0; j < 4; ++j) { qa[j] = QF[l * 65 + d0 + j]; qb[j] = QF[l * 65 + d0 + 4 + j]; ka[j] = KF[l * 65 + d0 + j]; kb[j] = KF[l * 65 + d0 + 4 + j]; }
        *(LAS u32x4*)(QB + (l * 72 + d0) * 2) = pg8::pack8(qa, qb);
        *(LAS u32x4*)(KB + (l * 72 + d0) * 2) = pg8::pack8(ka, kb);
        *(LAS u32x4*)(KBB + (l * 72 + d0) * 2) = pg8::pack8(ka * beta, kb * beta);
        *(u32x4*)(gQD + l * 64 + d0) = pg8::pack8(qa * eg, qb * eg);
        const int d = tid >> 3, l0 = (tid & 7) * 8; const float gl = GC[63]; f32x4 ta, tb;
#pragma unroll
        for (int j = 0; j < 4; ++j) { ta[j] = KF[(l0 + j) * 65 + d] * __expf(gl - GC[l0 + j]); tb[j] = KF[(l0 + 4 + j) * 65 + d] * __expf(gl - GC[l0 + 4 + j]); }
        *(u32x4*)(gKDT + d * 64 + l0) = pg8::pack8(ta, tb);
        if (tid == 0) gdec[item] = __expf(gl); }
    lds_barrier();
    { const int lt = wid >> 1;
#pragma unroll
        for (int t = 0; t < 2; ++t) { const int st = (wid & 1) * 2 + t; f32x4 akk = (f32x4){0.f, 0.f, 0.f, 0.f}, aqk = akk;
#pragma unroll
            for (int ks = 0; ks < 2; ++ks) { const bf16x8 bfr = lds_frag(KB + ((st * 16 + r) * 72 + ks * 32 + q * 8) * 2);
                akk = MFMA16(lds_frag(KBB + ((lt * 16 + r) * 72 + ks * 32 + q * 8) * 2), bfr, akk);
                aqk = MFMA16(lds_frag(QB + ((lt * 16 + r) * 72 + ks * 32 + q * 8) * 2), bfr, aqk); }
            const int s = st * 16 + r; const float gs = GC[s]; f32x4 mmv;
#pragma unroll
            for (int i = 0; i < 4; ++i) { const int l = lt * 16 + q * 4 + i; const float gam = (s <= l) ? __expf(GC[l] - gs) : 0.f;
                mmv[i] = (s < l) ? akk[i] * gam : 0.f;
                gQK[l * 64 + s] = (bf16_t)f2bf((s <= l) ? aqk[i] * gam : 0.f); }
            *(LAS f32x4*)(MM + s * 68 + lt * 16 + q * 4) = mmv; } }
    lds_barrier();
    { const int col = tid >> 2, k = tid & 3, j = col & 63; const bool isw = col >= 64; LAS float* SRC = isw ? KF : VF; LAS float* XL = (LAS float*)lds;
        bf16_t* dst = (isw ? gW : gU) + j;
#pragma unroll
        for (int bI = 0; bI < 4; ++bI) { const int lb = bI * 16 + 4 * k; float acc[4];
#pragma unroll
            for (int e = 0; e < 4; ++e) { const int l = lb + e; float a = SRC[l * 65 + j] * BETA[l]; if (isw) a *= __expf(GC[l]); acc[e] = a; }
            f32x4 dg[16];
#pragma unroll
            for (int i = 0; i < 16; ++i) dg[i] = *(const LAS f32x4*)(MM + (bI * 16 + i) * 68 + lb);
#pragma unroll 4
            for (int s = 0; s < bI * 16; ++s) { const float xs = XL[s * 128 + col]; const f32x4 mv = *(const LAS f32x4*)(MM + s * 68 + lb);
#pragma unroll
                for (int e = 0; e < 4; ++e) acc[e] -= mv[e] * xs; }
#pragma unroll
            for (int i = 0; i < 16; ++i) { const float own = acc[i & 3];
                const float xv = (i / 4 == 0) ? dppf<0x00>(own) : (i / 4 == 1) ? dppf<0x55>(own) : (i / 4 == 2) ? dppf<0xAA>(own) : dppf<0xFF>(own);
#pragma unroll
                for (int e = 0; e < 4; ++e) acc[e] -= dg[i][e] * xv; }
#pragma unroll
            for (int e = 0; e < 4; ++e) { const int l = lb + e; if (bI < 3) XL[l * 128 + col] = acc[e]; dst[l * 64] = (bf16_t)f2bf(acc[e]); } } }
    lds_barrier();
}

__device__ __forceinline__ void gdn_scan_item(LAS unsigned char* lds, const bf16_t* cols, const LayerP& P, const bf16_t* GP, const float* gdec, bf16_t* Y, int item) {
    const int tid = tid_o(), wid = tid >> 6, lane = tid & 63, r = lane & 15, q = lane >> 4;
    const int h = item & 3, b = item >> 2;
    constexpr int MB = 9216, DBB = 5 * MB;
    LAS unsigned char* DB = lds; LAS unsigned char* ST = lds + 2 * DBB; LAS unsigned char* VN = ST + MB; LAS float* OB = (LAS float*)(VN + MB);
    const int lt = wid >> 1, vt0 = (wid & 1) * 2;
    const int prow = tid >> 3, pcol = (tid & 7) * 8;
    f32x4 sacc[2] = {(f32x4){0.f, 0.f, 0.f, 0.f}, (f32x4){0.f, 0.f, 0.f, 0.f}};
    __syncthreads();
    for (int i = tid; i < MB / 4; i += NT) ((LAS unsigned*)ST)[i] = 0u;
    u32x4 pre[2][5];
    { const bf16_t* gp = GP + (size_t)((b * 64 + 0) * 4 + h) * (5 * 4096);
#pragma unroll
        for (int m = 0; m < 5; ++m) pre[0][m] = *(const u32x4*)(gp + m * 4096 + prow * 64 + pcol);
#pragma unroll
        for (int m = 0; m < 5; ++m) pre[1][m] = *(const u32x4*)(gp + 5 * 4096 * 4 + m * 4096 + prow * 64 + pcol);
#pragma unroll
        for (int m = 0; m < 5; ++m) *(LAS u32x4*)(DB + m * MB + (prow * 72 + pcol) * 2) = pre[0][m]; }
    __syncthreads();
    const int fl = tid >> 3, fv0 = (tid & 7) * 8;
    const f32x4 ga = *(const f32x4*)(P.gdn_norm_g + fv0), gb = *(const f32x4*)(P.gdn_norm_g + fv0 + 4);
    u32x4 zn = *(const u32x4*)(cols + ((size_t)b * SEQ + fl) * LDC + GDN_Z + h * 64 + fv0);
    float decn = gdec[(b * 64 + 0) * 4 + h];
    for (int c2 = 0; c2 < 64; c2 += 2) {
#pragma unroll
      for (int u = 0; u < 2; ++u) { const int c = c2 + u;
        const u32x4 zz = zn; const float dec = decn;
        if (c + 1 < 64) { zn = *(const u32x4*)(cols + ((size_t)b * SEQ + (c + 1) * 64 + fl) * LDC + GDN_Z + h * 64 + fv0); decn = gdec[(b * 64 + c + 1) * 4 + h]; }
        LAS unsigned char* cur = DB + u * DBB; LAS unsigned char* nxt = DB + (u ^ 1) * DBB;
        LAS unsigned char* mU = cur; LAS unsigned char* mW = cur + MB; LAS unsigned char* mQK = cur + 2 * MB; LAS unsigned char* mQD = cur + 3 * MB; LAS unsigned char* mKDT = cur + 4 * MB;
        if (c + 2 < 64) { const bf16_t* gp = GP + (size_t)((b * 64 + c + 2) * 4 + h) * (5 * 4096);
#pragma unroll
            for (int m = 0; m < 5; ++m) pre[u][m] = *(const u32x4*)(gp + m * 4096 + prow * 64 + pcol); }
        f32x4 ao[2];
#pragma unroll
        for (int t = 0; t < 2; ++t) { const int vt = vt0 + t; f32x4 aws = (f32x4){0.f, 0.f, 0.f, 0.f}; ao[t] = aws;
#pragma unroll
            for (int ks = 0; ks < 2; ++ks) { const bf16x8 bfr = lds_frag(ST + ((vt * 16 + r) * 72 + ks * 32 + q * 8) * 2);
                aws = MFMA16(lds_frag(mW + ((lt * 16 + r) * 72 + ks * 32 + q * 8) * 2), bfr, aws);
                ao[t] = MFMA16(lds_frag(mQD + ((lt * 16 + r) * 72 + ks * 32 + q * 8) * 2), bfr, ao[t]); }
            f32x4 vn;
#pragma unroll
            for (int i = 0; i < 4; ++i) vn[i] = bf2f(*(const LAS bf16_t*)(mU + ((lt * 16 + q * 4 + i) * 72 + vt * 16 + r) * 2)) - aws[i];
            u32x2 w2; w2.x = pk2(vn[0], vn[1]); w2.y = pk2(vn[2], vn[3]);
            *(LAS u32x2*)(VN + ((vt * 16 + r) * 72 + lt * 16 + q * 4) * 2) = w2; }
        lds_barrier();
#pragma unroll
        for (int t = 0; t < 2; ++t) { const int vt = vt0 + t; sacc[t] = sacc[t] * dec;
#pragma unroll
            for (int ks = 0; ks < 2; ++ks) { const bf16x8 bfr = lds_frag(VN + ((vt * 16 + r) * 72 + ks * 32 + q * 8) * 2);
                ao[t] = MFMA16(lds_frag(mQK + ((lt * 16 + r) * 72 + ks * 32 + q * 8) * 2), bfr, ao[t]);
                sacc[t] = MFMA16(lds_frag(mKDT + ((lt * 16 + r) * 72 + ks * 32 + q * 8) * 2), bfr, sacc[t]); }
#pragma unroll
            for (int i = 0; i < 4; ++i) OB[(lt * 16 + q * 4 + i) * 68 + vt * 16 + r] = ao[t][i];
            u32x2 w2; w2.x = pk2(sacc[t][0], sacc[t][1]); w2.y = pk2(sacc[t][2], sacc[t][3]);
            *(LAS u32x2*)(ST + ((vt * 16 + r) * 72 + lt * 16 + q * 4) * 2) = w2; }
        if (c + 1 < 64) {
#pragma unroll
            for (int m = 0; m < 5; ++m) *(LAS u32x4*)(nxt + m * MB + (prow * 72 + pcol) * 2) = pre[u ^ 1][m]; }
        lds_barrier();
        { const int l = tid >> 3, v0 = (tid & 7) * 8; const size_t tok = (size_t)b * SEQ + c * 64 + l;
            const f32x4 oa = *(const LAS f32x4*)(OB + l * 68 + v0), ob = *(const LAS f32x4*)(OB + l * 68 + v0 + 4);
            float s = 0.f;
#pragma unroll
            for (int j = 0; j < 4; ++j) s += oa[j] * oa[j] + ob[j] * ob[j];
            s = row8_sum(s);
            const float rs = __builtin_amdgcn_rsqf(s * (1.f / 64.f) + EPS);
            f32x4 ra, rb;
            ra[0] = oa[0] * rs * ga[0] * silu_f(bflo(zz.x)); ra[1] = oa[1] * rs * ga[1] * silu_f(bfhi(zz.x));
            ra[2] = oa[2] * rs * ga[2] * silu_f(bflo(zz.y)); ra[3] = oa[3] * rs * ga[3] * silu_f(bfhi(zz.y));
            rb[0] = ob[0] * rs * gb[0] * silu_f(bflo(zz.z)); rb[1] = ob[1] * rs * gb[1] * silu_f(bfhi(zz.z));
            rb[2] = ob[2] * rs * gb[2] * silu_f(bflo(zz.w)); rb[3] = ob[3] * rs * gb[3] * silu_f(bfhi(zz.w));
            *(u32x4*)(Y + tok * 1024 + 768 + h * 64 + v0) = pg8::pack8(ra, rb); }
      }
    }
    __syncthreads();
}

__device__ __forceinline__ void ssd_scan_item(LAS unsigned char* lds, const bf16_t* cols, const LayerP& P, bf16_t* Y, float* ssdp, int item) {
    const int tid = tid_o(), wid = tid >> 6, lane = tid & 63, r = lane & 15, q = lane >> 4;
    const int hd = item & 7, b = item >> 3, g = hd >> 2;
    constexpr int MB = 9216;
    LAS bf16_t* RAW = (LAS bf16_t*)lds;
    LAS unsigned char* XT = lds + 25856; LAS unsigned char* BM_ = XT + MB; LAS unsigned char* BTS = BM_ + MB; LAS unsigned char* CM = BTS + MB;
    LAS unsigned char* HC = CM + MB; LAS unsigned char* GM = HC + MB;
    LAS float* DT = (LAS float*)(GM + MB); LAS float* AC = DT + 64;
    const int lt = wid >> 1, pt0 = (wid & 1) * 2;
    const float a_h = -__expf(P.ssd_a_log[hd]), dtb = P.ssd_dt_bias[hd], dsk = P.ssd_d[hd];
    const int ch = tid % 192, l0 = tid / 192;
    int cc;
    if (ch < 64) cc = hd * 64 + ch; else if (ch < 128) cc = 512 + g * 64 + (ch - 64); else cc = 640 + g * 64 + (ch - 128);
    float w0 = 0.f, w1 = 0.f, w2 = 0.f, w3 = 0.f, cb = 0.f;
    if (tid < 384) { w0 = P.ssd_conv_w[cc]; w1 = P.ssd_conv_w[768 + cc]; w2 = P.ssd_conv_w[1536 + cc]; w3 = P.ssd_conv_w[2304 + cc]; cb = P.ssd_conv_b[cc]; }
    f32x4 hacc[2] = {(f32x4){0.f, 0.f, 0.f, 0.f}, (f32x4){0.f, 0.f, 0.f, 0.f}};
    __syncthreads();
    for (int i = tid; i < MB / 4; i += NT) ((LAS unsigned*)HC)[i] = 0u;
    u32x4 pre[4];
#define SSD_LOAD_RAW(cidx) do { _Pragma("unroll") for (int k = 0; k < 4; ++k) { const int i = tid + k * NT; pre[k] = (u32x4){0u, 0u, 0u, 0u}; \
        if (i < 67 * 24) { const int rr = i / 24, rem = i % 24, p = rem >> 3, pc = rem & 7; const int t = (cidx) * 64 - 3 + rr; \
            const int colb = (p == 0) ? (SSD_XBC + hd * 64) : (p == 1 ? SSD_XBC + 512 + g * 64 : SSD_XBC + 640 + g * 64); \
            if (t >= 0) pre[k] = *(const u32x4*)(cols + ((size_t)b * SEQ + t) * LDC + colb + pc * 8); } } } while (0)
#define SSD_STORE_RAW() do { _Pragma("unroll") for (int k = 0; k < 4; ++k) { const int i = tid + k * NT; \
        if (i < 67 * 24) { const int rr = i / 24, rem = i % 24, p = rem >> 3, pc = rem & 7; *(LAS u32x4*)(RAW + rr * 192 + p * 64 + pc * 8) = pre[k]; } } } while (0)
    SSD_LOAD_RAW(0); SSD_STORE_RAW();
    float dtrn = 0.f; if (wid == 6) dtrn = bf2f(cols[((size_t)b * SEQ + lane) * LDC + SSD_DT + hd]);
    bf16_t zn[8];
#pragma unroll
    for (int t = 0; t < 2; ++t)
#pragma unroll
        for (int i = 0; i < 4; ++i) zn[t * 4 + i] = cols[((size_t)b * SEQ + lt * 16 + q * 4 + i) * LDC + SSD_Z + hd * 64 + (pt0 + t) * 16 + r];
    __syncthreads();
    for (int c = 0; c < 64; ++c) {
        const size_t tok0 = (size_t)b * SEQ + (size_t)c * 64;
        if (c + 1 < 64) SSD_LOAD_RAW(c + 1);
        bf16_t zc[8];
#pragma unroll
        for (int k = 0; k < 8; ++k) zc[k] = zn[k];
        if (c + 1 < 64) {
#pragma unroll
            for (int t = 0; t < 2; ++t)
#pragma unroll
                for (int i = 0; i < 4; ++i) zn[t * 4 + i] = cols[(tok0 + 64 + lt * 16 + q * 4 + i) * LDC + SSD_Z + hd * 64 + (pt0 + t) * 16 + r]; }
        if (tid < 384) {
            const int lb = l0 * 32; float x0 = bf2f(RAW[lb * 192 + ch]), x1 = bf2f(RAW[(lb + 1) * 192 + ch]), x2 = bf2f(RAW[(lb + 2) * 192 + ch]);
#pragma unroll 4
            for (int j = 0; j < 32; ++j) { const int l = lb + j; const float x3 = bf2f(RAW[(l + 3) * 192 + ch]);
                const float y = silu_f(cb + w0 * x0 + w1 * x1 + w2 * x2 + w3 * x3); x0 = x1; x1 = x2; x2 = x3;
                const bf16_t yb = (bf16_t)f2bf(y);
                if (ch < 64) *(LAS bf16_t*)(XT + (ch * 72 + l) * 2) = yb;
                else if (ch < 128) *(LAS bf16_t*)(BM_ + (l * 72 + ch - 64) * 2) = yb;
                else *(LAS bf16_t*)(CM + (l * 72 + ch - 128) * 2) = yb; }
        } else if (wid == 6) {
            const float dt = softplus_f(dtrn + dtb); float ac = dt * a_h;
#pragma unroll
            for (int o = 1; o < 64; o <<= 1) { const float t = bperm_f(ac, lane - o); if (lane >= o) ac += t; }
            DT[lane] = dt; AC[lane] = ac;
            if (c + 1 < 64) dtrn = bf2f(cols[(tok0 + 64 + lane) * LDC + SSD_DT + hd]); }
        __syncthreads();
        const float ac63 = AC[63];
        { const int n = tid >> 3, lb = (tid & 7) * 8; f32x4 ta, tb;
#pragma unroll
            for (int j = 0; j < 4; ++j) { ta[j] = bf2f(*(const LAS bf16_t*)(BM_ + ((lb + j) * 72 + n) * 2)) * DT[lb + j] * __expf(ac63 - AC[lb + j]);
                tb[j] = bf2f(*(const LAS bf16_t*)(BM_ + ((lb + 4 + j) * 72 + n) * 2)) * DT[lb + 4 + j] * __expf(ac63 - AC[lb + 4 + j]); }
            *(LAS u32x4*)(BTS + (n * 72 + lb) * 2) = pg8::pack8(ta, tb); }
#pragma unroll
        for (int t = 0; t < 2; ++t) { const int st = pt0 + t; f32x4 a = (f32x4){0.f, 0.f, 0.f, 0.f};
#pragma unroll
            for (int ks = 0; ks < 2; ++ks) a = MFMA16(lds_frag(CM + ((lt * 16 + r) * 72 + ks * 32 + q * 8) * 2), lds_frag(BM_ + ((st * 16 + r) * 72 + ks * 32 + q * 8) * 2), a);
            const int s = st * 16 + r; const float as = AC[s], ds = DT[s];
#pragma unroll
            for (int i = 0; i < 4; ++i) { const int l = lt * 16 + q * 4 + i; const float gv = (s <= l) ? a[i] * __expf(AC[l] - as) * ds : 0.f;
                *(LAS bf16_t*)(GM + (l * 72 + s) * 2) = (bf16_t)f2bf(gv); } }
        __syncthreads();
        float ssq[4] = {0.f, 0.f, 0.f, 0.f};
#pragma unroll
        for (int t = 0; t < 2; ++t) { const int pt = pt0 + t; f32x4 yd = (f32x4){0.f, 0.f, 0.f, 0.f}, yo = yd;
#pragma unroll
            for (int ks = 0; ks < 2; ++ks) {
                yd = MFMA16(lds_frag(GM + ((lt * 16 + r) * 72 + ks * 32 + q * 8) * 2), lds_frag(XT + ((pt * 16 + r) * 72 + ks * 32 + q * 8) * 2), yd);
                yo = MFMA16(lds_frag(CM + ((lt * 16 + r) * 72 + ks * 32 + q * 8) * 2), lds_frag(HC + ((pt * 16 + r) * 72 + ks * 32 + q * 8) * 2), yo); }
            const int p = pt * 16 + r; const u32x2 xw = *(const LAS u32x2*)(XT + (p * 72 + lt * 16 + q * 4) * 2);
            const float xs4[4] = {bflo(xw.x), bfhi(xw.x), bflo(xw.y), bfhi(xw.y)};
#pragma unroll
            for (int i = 0; i < 4; ++i) { const int l = lt * 16 + q * 4 + i; const size_t tok = tok0 + l;
                float y = yd[i] + __expf(AC[l]) * yo[i] + dsk * xs4[i];
                y *= silu_f(bf2f(zc[t * 4 + i]));
                ssq[i] += y * y;
                Y[tok * 1024 + hd * 64 + p] = (bf16_t)f2bf(y); } }
#pragma unroll
        for (int i = 0; i < 4; ++i) { float s = ssq[i]; s += __shfl_xor(s, 1); s += __shfl_xor(s, 2); s += __shfl_xor(s, 4); s += __shfl_xor(s, 8);
            if (r == 0) ssdp[(tok0 + lt * 16 + q * 4 + i) * 16 + hd * 2 + (wid & 1)] = s; }
        { const float dec = __expf(ac63);
#pragma unroll
            for (int t = 0; t < 2; ++t) { const int pt = pt0 + t; hacc[t] = hacc[t] * dec;
#pragma unroll
                for (int ks = 0; ks < 2; ++ks) hacc[t] = MFMA16(lds_frag(BTS + ((lt * 16 + r) * 72 + ks * 32 + q * 8) * 2), lds_frag(XT + ((pt * 16 + r) * 72 + ks * 32 + q * 8) * 2), hacc[t]); } }
        __syncthreads();
#pragma unroll
        for (int t = 0; t < 2; ++t) { const int pt = pt0 + t; u32x2 w2; w2.x = pk2(hacc[t][0], hacc[t][1]); w2.y = pk2(hacc[t][2], hacc[t][3]);
            *(LAS u32x2*)(HC + ((pt * 16 + r) * 72 + lt * 16 + q * 4) * 2) = w2; }
        if (c + 1 < 64) SSD_STORE_RAW();
        __syncthreads();
    }
#undef SSD_LOAD_RAW
#undef SSD_STORE_RAW
}

__device__ __forceinline__ void ssd_prep_range(LAS unsigned char* lds, const bf16_t* cols, const LayerP& P, bf16_t* Y, bf16_t* SST, float* SAC, bf16_t* CMS, int b, int hd, int c0, int c1) {
    const int tid = tid_o(), wid = tid >> 6, lane = tid & 63, r = lane & 15, q = lane >> 4;
    const int g = hd >> 2;
    constexpr int MB = 9216;
    LAS bf16_t* RAW = (LAS bf16_t*)lds;
    LAS unsigned char* XT = lds + 25856; LAS unsigned char* BM_ = XT + MB; LAS unsigned char* BTS = BM_ + MB; LAS unsigned char* CM = BTS + MB; LAS unsigned char* GM = CM + MB;
    LAS float* DT = (LAS float*)(GM + MB); LAS float* AC = DT + 64;
    const int lt = wid >> 1, pt0 = (wid & 1) * 2;
    const float a_h = -__expf(P.ssd_a_log[hd]), dtb = P.ssd_dt_bias[hd], dsk = P.ssd_d[hd];
    const int ch = tid % 192, l0 = tid / 192;
    int cc;
    if (ch < 64) cc = hd * 64 + ch; else if (ch < 128) cc = 512 + g * 64 + (ch - 64); else cc = 640 + g * 64 + (ch - 128);
    float w0 = 0.f, w1 = 0.f, w2 = 0.f, w3 = 0.f, cb = 0.f;
    if (tid < 384) { w0 = P.ssd_conv_w[cc]; w1 = P.ssd_conv_w[768 + cc]; w2 = P.ssd_conv_w[1536 + cc]; w3 = P.ssd_conv_w[2304 + cc]; cb = P.ssd_conv_b[cc]; }
    u32x4 pre[4];
#define SSD_LOAD_RAW(cidx) do { _Pragma("unroll") for (int k = 0; k < 4; ++k) { const int i = tid + k * NT; pre[k] = (u32x4){0u, 0u, 0u, 0u}; \
        if (i < 67 * 24) { const int rr = i / 24, rem = i % 24, p = rem >> 3, pc = rem & 7; const int t = (cidx) * 64 - 3 + rr; \
            const int colb = (p == 0) ? (SSD_XBC + hd * 64) : (p == 1 ? SSD_XBC + 512 + g * 64 : SSD_XBC + 640 + g * 64); \
            if (t >= 0) pre[k] = *(const u32x4*)(cols + ((size_t)b * SEQ + t) * LDC + colb + pc * 8); } } } while (0)
#define SSD_STORE_RAW() do { _Pragma("unroll") for (int k = 0; k < 4; ++k) { const int i = tid + k * NT; \
        if (i < 67 * 24) { const int rr = i / 24, rem = i % 24, p = rem >> 3, pc = rem & 7; *(LAS u32x4*)(RAW + rr * 192 + p * 64 + pc * 8) = pre[k]; } } } while (0)
    __syncthreads();
    SSD_LOAD_RAW(c0); SSD_STORE_RAW();
    float dtrn = 0.f; if (wid == 6) dtrn = bf2f(cols[((size_t)b * SEQ + c0 * 64 + lane) * LDC + SSD_DT + hd]);
    __syncthreads();
    for (int c = c0; c < c1; ++c) {
        const size_t tok0 = (size_t)b * SEQ + (size_t)c * 64; const size_t it = (size_t)(b * 8 + hd) * 64 + c;
        if (c + 1 < c1) SSD_LOAD_RAW(c + 1);
        if (tid < 384) {
            const int lb = l0 * 32; float x0 = bf2f(RAW[lb * 192 + ch]), x1 = bf2f(RAW[(lb + 1) * 192 + ch]), x2 = bf2f(RAW[(lb + 2) * 192 + ch]);
#pragma unroll 4
            for (int j = 0; j < 32; ++j) { const int l = lb + j; const float x3 = bf2f(RAW[(l + 3) * 192 + ch]);
                const float y = silu_f(cb + w0 * x0 + w1 * x1 + w2 * x2 + w3 * x3); x0 = x1; x1 = x2; x2 = x3;
                const bf16_t yb = (bf16_t)f2bf(y);
                if (ch < 64) *(LAS bf16_t*)(XT + (ch * 72 + l) * 2) = yb;
                else if (ch < 128) *(LAS bf16_t*)(BM_ + (l * 72 + ch - 64) * 2) = yb;
                else *(LAS bf16_t*)(CM + (l * 72 + ch - 128) * 2) = yb; }
        } else if (wid == 6) {
            const float dt = softplus_f(dtrn + dtb); float ac = dt * a_h;
#pragma unroll
            for (int o = 1; o < 64; o <<= 1) { const float t = bperm_f(ac, lane - o); if (lane >= o) ac += t; }
            DT[lane] = dt; AC[lane] = ac; SAC[it * 64 + lane] = ac;
            if (c + 1 < c1) dtrn = bf2f(cols[(tok0 + 64 + lane) * LDC + SSD_DT + hd]); }
        lds_barrier();
        const float ac63 = AC[63];
        { const int n = tid >> 3, lb = (tid & 7) * 8; f32x4 ta, tb;
#pragma unroll
            for (int j = 0; j < 4; ++j) { ta[j] = bf2f(*(const LAS bf16_t*)(BM_ + ((lb + j) * 72 + n) * 2)) * DT[lb + j] * __expf(ac63 - AC[lb + j]);
                tb[j] = bf2f(*(const LAS bf16_t*)(BM_ + ((lb + 4 + j) * 72 + n) * 2)) * DT[lb + 4 + j] * __expf(ac63 - AC[lb + 4 + j]); }
            *(LAS u32x4*)(BTS + (n * 72 + lb) * 2) = pg8::pack8(ta, tb);
            if ((hd & 3) == 0) *(u32x4*)(CMS + ((size_t)((b * 64 + c) * 2 + g)) * 4096 + n * 64 + lb) = *(const LAS u32x4*)(CM + (n * 72 + lb) * 2); }
#pragma unroll
        for (int t = 0; t < 2; ++t) { const int st = pt0 + t; f32x4 a = (f32x4){0.f, 0.f, 0.f, 0.f};
#pragma unroll
            for (int ks = 0; ks < 2; ++ks) a = MFMA16(lds_frag(CM + ((lt * 16 + r) * 72 + ks * 32 + q * 8) * 2), lds_frag(BM_ + ((st * 16 + r) * 72 + ks * 32 + q * 8) * 2), a);
            const int s_ = st * 16 + r; const float as = AC[s_], ds = DT[s_];
#pragma unroll
            for (int i = 0; i < 4; ++i) { const int l = lt * 16 + q * 4 + i; const float gv = (s_ <= l) ? a[i] * __expf(AC[l] - as) * ds : 0.f;
                *(LAS bf16_t*)(GM + (l * 72 + s_) * 2) = (bf16_t)f2bf(gv); } }
        lds_barrier();
#pragma unroll
        for (int t = 0; t < 2; ++t) { const int pt = pt0 + t; f32x4 yd = (f32x4){0.f, 0.f, 0.f, 0.f}, sc = yd;
#pragma unroll
            for (int ks = 0; ks < 2; ++ks) {
                const bf16x8 xf = lds_frag(XT + ((pt * 16 + r) * 72 + ks * 32 + q * 8) * 2);
                yd = MFMA16(lds_frag(GM + ((lt * 16 + r) * 72 + ks * 32 + q * 8) * 2), xf, yd);
                sc = MFMA16(lds_frag(BTS + ((lt * 16 + r) * 72 + ks * 32 + q * 8) * 2), xf, sc); }
            const int p = pt * 16 + r; const u32x2 xw = *(const LAS u32x2*)(XT + (p * 72 + lt * 16 + q * 4) * 2);
            const float xs4[4] = {bflo(xw.x), bfhi(xw.x), bflo(xw.y), bfhi(xw.y)};
#pragma unroll
            for (int i = 0; i < 4; ++i) Y[(tok0 + lt * 16 + q * 4 + i) * 1024 + hd * 64 + p] = (bf16_t)f2bf(yd[i] + dsk * xs4[i]);
            u32x2 w2; w2.x = pk2(sc[0], sc[1]); w2.y = pk2(sc[2], sc[3]);
            *(u32x2*)(SST + it * 4096 + p * 64 + lt * 16 + q * 4) = w2; }
        if (c + 1 < c1) SSD_STORE_RAW();
        lds_barrier();
    }
#undef SSD_LOAD_RAW
#undef SSD_STORE_RAW
}
__device__ __forceinline__ void ssd_state_scan_item(LAS unsigned char* lds, bf16_t* SST, const float* SAC, int item) {
    const int tid = tid_o(); LAS float* DEC = (LAS float*)lds;
    __syncthreads();
    if (tid < 64) DEC[tid] = __expf(SAC[((size_t)item * 64 + tid) * 64 + 63]);
    __syncthreads();
    bf16_t* base = SST + (size_t)item * 64 * 4096 + tid * 8;
    f32x4 ha = (f32x4){0.f, 0.f, 0.f, 0.f}, hb2 = ha;
    u32x4 sv[4];
#pragma unroll
    for (int k = 0; k < 4; ++k) sv[k] = *(const u32x4*)(base + (size_t)k * 4096);
    for (int c4 = 0; c4 < 64; c4 += 4) {
#pragma unroll
        for (int k = 0; k < 4; ++k) { const int c = c4 + k; const u32x4 w = sv[k];
            if (c + 4 < 64) sv[k] = *(const u32x4*)(base + (size_t)(c + 4) * 4096);
            *(u32x4*)(base + (size_t)c * 4096) = pg8::pack8(ha, hb2);
            const float d = DEC[c];
            ha[0] = ha[0] * d + bflo(w.x); ha[1] = ha[1] * d + bfhi(w.x); ha[2] = ha[2] * d + bflo(w.y); ha[3] = ha[3] * d + bfhi(w.y);
            hb2[0] = hb2[0] * d + bflo(w.z); hb2[1] = hb2[1] * d + bfhi(w.z); hb2[2] = hb2[2] * d + bflo(w.w); hb2[3] = hb2[3] * d + bfhi(w.w); } }
}
__device__ __forceinline__ void ssd_finish_item(LAS unsigned char* lds, const bf16_t* cols, const float* ng, bf16_t* Y, const bf16_t* SST, const float* SAC, const bf16_t* CMS, int item) {
    const int tid = tid_o(), wid = tid >> 6, lane = tid & 63, r = lane & 15, q = lane >> 4;
    const int g = item & 1, c = (item >> 1) & 63, b = item >> 7;
    constexpr int MB = 9216;
    LAS unsigned char* CM = lds; LAS unsigned char* HC = lds + MB; LAS float* ACS = (LAS float*)(lds + 5 * MB); LAS float* SSQ = ACS + 256;
    const int prow = tid >> 3, pcol = (tid & 7) * 8;
    lds_barrier();
    *(LAS u32x4*)(CM + (prow * 72 + pcol) * 2) = *(const u32x4*)(CMS + (size_t)item * 4096 + prow * 64 + pcol);
#pragma unroll
    for (int hh = 0; hh < 4; ++hh) *(LAS u32x4*)(HC + hh * MB + (prow * 72 + pcol) * 2) = *(const u32x4*)(SST + ((size_t)(b * 8 + g * 4 + hh) * 64 + c) * 4096 + prow * 64 + pcol);
    if (tid < 256) ACS[tid] = SAC[((size_t)(b * 8 + g * 4 + (tid >> 6)) * 64 + c) * 64 + (tid & 63)];
    lds_barrier();
    const int hh = wid >> 1, half = wid & 1, hd = g * 4 + hh; const size_t tok0 = (size_t)b * SEQ + (size_t)c * 64;
    float yv[2][4][4]; float ssq[2][4];
#pragma unroll
    for (int a = 0; a < 2; ++a) { const int lt = half * 2 + a;
#pragma unroll
        for (int i = 0; i < 4; ++i) ssq[a][i] = 0.f;
#pragma unroll
        for (int pt = 0; pt < 4; ++pt) { f32x4 yo = (f32x4){0.f, 0.f, 0.f, 0.f};
#pragma unroll
            for (int ks = 0; ks < 2; ++ks) yo = MFMA16(lds_frag(CM + ((lt * 16 + r) * 72 + ks * 32 + q * 8) * 2), lds_frag(HC + hh * MB + ((pt * 16 + r) * 72 + ks * 32 + q * 8) * 2), yo);
            const int p = pt * 16 + r;
#pragma unroll
            for (int i = 0; i < 4; ++i) { const int l = lt * 16 + q * 4 + i; const size_t tok = tok0 + l;
                float y = bf2f(Y[tok * 1024 + hd * 64 + p]) + __expf(ACS[hh * 64 + l]) * yo[i];
                y *= silu_f(bf2f(cols[tok * LDC + SSD_Z + hd * 64 + p]));
                yv[a][pt][i] = y; ssq[a][i] += y * y; } }
#pragma unroll
        for (int i = 0; i < 4; ++i) { float s_ = row16_sum(ssq[a][i]);
            if (r == 0) SSQ[(lt * 16 + q * 4 + i) * 4 + hh] = s_; } }
    lds_barrier();
#pragma unroll
    for (int a = 0; a < 2; ++a) { const int lt = half * 2 + a;
#pragma unroll
        for (int i = 0; i < 4; ++i) { const int l = lt * 16 + q * 4 + i; const f32x4 sq = *(const LAS f32x4*)(SSQ + l * 4);
            const float rs = __builtin_amdgcn_rsqf(((sq[0] + sq[1]) + (sq[2] + sq[3])) * (1.f / 256.f) + EPS);
#pragma unroll
            for (int pt = 0; pt < 4; ++pt) { const int p = pt * 16 + r; Y[(tok0 + l) * 1024 + hd * 64 + p] = (bf16_t)f2bf(yv[a][pt][i] * rs * ng[hd * 64 + p]); } } }
}

__device__ __forceinline__ void ssd_fixup(bf16_t* Y, const float* ssdp, const float* ng) {
    const int gt = bid_o() * NT + tid_o(), gn = gridDim.x * NT;
    for (int i = gt; i < T * 64; i += gn) { const int tok = i >> 6, c0 = (i & 63) * 8, g = c0 >> 8;
        const f32x4 pa = *(const f32x4*)(ssdp + (size_t)tok * 16 + g * 8), pb = *(const f32x4*)(ssdp + (size_t)tok * 16 + g * 8 + 4);
        const float s = (pa[0] + pa[1]) + (pa[2] + pa[3]) + (pb[0] + pb[1]) + (pb[2] + pb[3]);
        const float rs = __builtin_amdgcn_rsqf(s * (1.f / 256.f) + EPS);
        bf16_t* yp = Y + (size_t)tok * 1024 + c0; const u32x4 v = *(const u32x4*)yp;
        const f32x4 ga = *(const f32x4*)(ng + c0), gb = *(const f32x4*)(ng + c0 + 4);
        f32x4 a, b2;
        a[0] = bflo(v.x) * rs * ga[0]; a[1] = bfhi(v.x) * rs * ga[1]; a[2] = bflo(v.y) * rs * ga[2]; a[3] = bfhi(v.y) * rs * ga[3];
        b2[0] = bflo(v.z) * rs * gb[0]; b2[1] = bfhi(v.z) * rs * gb[1]; b2[2] = bflo(v.w) * rs * gb[2]; b2[3] = bfhi(v.w) * rs * gb[3];
        *(u32x4*)yp = pg8::pack8(a, b2); }
}
__device__ __forceinline__ void post_rows(const bf16_t* tb, float* h, float cres, const float* gpost, const float* gnext, bf16_t* hb) {
    const int tix = tid_o(); const int lane = tix & 63, gw = bid_o() * (NT / 64) + (tix >> 6), nw = gridDim.x * (NT / 64);
    f32x4 gp[4], gn[4];
#pragma unroll
    for (int j = 0; j < 4; ++j) { gp[j] = *((const f32x4*)gpost + lane + 64 * j); gn[j] = gnext ? *((const f32x4*)gnext + lane + 64 * j) : (f32x4){0.f, 0.f, 0.f, 0.f}; }
    u32x2 tn[4]; f32x4 hn[4];
    if (gw < T) {
#pragma unroll
        for (int j = 0; j < 4; ++j) { tn[j] = *((const u32x2*)(tb + (size_t)gw * D) + lane + 64 * j); hn[j] = *((const f32x4*)(h + (size_t)gw * D) + lane + 64 * j); } }
    for (int row = gw; row < T; row += nw) {
        f32x4 tv[4], hv[4]; float s = 0.f;
#pragma unroll
        for (int j = 0; j < 4; ++j) { tv[j] = (f32x4){bflo(tn[j].x), bfhi(tn[j].x), bflo(tn[j].y), bfhi(tn[j].y)}; hv[j] = hn[j]; }
        if (row + nw < T) {
#pragma unroll
            for (int j = 0; j < 4; ++j) { tn[j] = *((const u32x2*)(tb + (size_t)(row + nw) * D) + lane + 64 * j); hn[j] = *((const f32x4*)(h + (size_t)(row + nw) * D) + lane + 64 * j); } }
#pragma unroll
        for (int j = 0; j < 4; ++j) s += (tv[j][0] * tv[j][0] + tv[j][1] * tv[j][1]) + (tv[j][2] * tv[j][2] + tv[j][3] * tv[j][3]);
        const float rs = __builtin_amdgcn_rsqf(wave_sum(s, lane) * (1.f / D) + EPS) * cres; float s2 = 0.f; f32x4* hp = (f32x4*)(h + (size_t)row * D) + lane;
#pragma unroll
        for (int j = 0; j < 4; ++j) { hv[j] = hv[j] + tv[j] * rs * gp[j]; hp[64 * j] = hv[j];
            s2 += (hv[j][0] * hv[j][0] + hv[j][1] * hv[j][1]) + (hv[j][2] * hv[j][2] + hv[j][3] * hv[j][3]); }
        if (gnext) { const float r2 = __builtin_amdgcn_rsqf(wave_sum(s2, lane) * (1.f / D) + EPS); u32x2* op = (u32x2*)(hb + (size_t)row * D) + lane;
#pragma unroll
            for (int j = 0; j < 4; ++j) { const f32x4 o = hv[j] * r2 * gn[j]; u32x2 w; w.x = pk2(o[0], o[1]); w.y = pk2(o[2], o[3]); op[64 * j] = w; } }
    }
}
__device__ __forceinline__ void norm_rows(const float* x, int nrows, const float* g, bf16_t* o, float* cp) {
    const int tix = tid_o(); const int lane = tix & 63, gw = bid_o() * (NT / 64) + (tix >> 6), nw = gridDim.x * (NT / 64);
    for (int row = gw; row < nrows; row += nw) {
        const f32x4* xp = (const f32x4*)(x + (size_t)row * D) + lane; f32x4 v[4]; float s = 0.f;
#pragma unroll
        for (int j = 0; j < 4; ++j) { v[j] = xp[64 * j]; s += (v[j][0] * v[j][0] + v[j][1] * v[j][1]) + (v[j][2] * v[j][2] + v[j][3] * v[j][3]); }
        const float rs = __builtin_amdgcn_rsqf(wave_sum(s, lane) * (1.f / D) + EPS); u32x2* op = (u32x2*)(o + (size_t)row * D) + lane;
#pragma unroll
        for (int j = 0; j < 4; ++j) { const f32x4 gn = *((const f32x4*)g + lane + 64 * j); const f32x4 ov = v[j] * rs * gn; u32x2 w; w.x = pk2(ov[0], ov[1]); w.y = pk2(ov[2], ov[3]); op[64 * j] = w;
            if (cp) ((f32x4*)(cp + (size_t)row * D) + lane)[64 * j] = v[j]; }
    }
}
__device__ __forceinline__ int map_col(int kind, int n, int Nsrc) {
    if (kind == 0) return n < Nsrc ? n : -1;
    if (kind == 1) { const int tile = n >> 8, c = n & 255; return c < 128 ? tile * 128 + c : FF + tile * 128 + (c - 128); }
    if (n >= 384) return -1;
    const int h = n / 96, e = n % 96; if (e < 64) return n;
    const int pos = e - 64, a = pos >> 3, nn = (pos >> 2) & 1, jj = pos & 3; return h * 96 + 64 + nn * 16 + 4 * a + jj;
}
__device__ __forceinline__ void convert_w(LAS unsigned char* lds, const float* W, int K, int Nsrc, int Ndst, bf16_t* Wt, int kind, const float* kscale) {
    LAS float* tile = (LAS float*)lds;
    const int tid = tid_o(), tn = tid & 63, tk = tid >> 6;
    const int nkt = K / 64, nitems = (Ndst / 64) * nkt, G = gridDim.x;
    float v[8];
#define CW_LOAD(IT_) do { const int n0_ = ((IT_) / nkt) * 64, k0_ = ((IT_) % nkt) * 64; const int col = map_col(kind, n0_ + tn, Nsrc); \
        _Pragma("unroll") for (int kk = 0; kk < 8; ++kk) { const int kl = tk + 8 * kk; float x = 0.f; \
            if (col >= 0) { x = W[(size_t)(k0_ + kl) * Nsrc + col]; if (kscale) x *= kscale[k0_ + kl]; } v[kk] = x; } } while (0)
    int it = bid_o();
    __syncthreads();
    if (it < nitems) CW_LOAD(it);
    for (; it < nitems; it += G) { const int n0 = (it / nkt) * 64, k0 = (it % nkt) * 64;
        lds_barrier();
#pragma unroll
        for (int kk = 0; kk < 8; ++kk) tile[tn * 65 + tk + 8 * kk] = v[kk];
        lds_barrier();
        if (it + G < nitems) CW_LOAD(it + G);
        const int row = tid >> 3, ck = (tid & 7) * 8; f32x4 a, b;
#pragma unroll
        for (int j = 0; j < 4; ++j) { a[j] = tile[row * 65 + ck + j]; b[j] = tile[row * 65 + ck + 4 + j]; }
        *(u32x4*)(Wt + (size_t)(n0 + row) * K + k0 + ck) = pg8::pack8(a, b); }
#undef CW_LOAD
    __syncthreads();
}

template <int KC>
__device__ __forceinline__ void row_scales(const bf16_t* A, LAS float* rsl, float sc) {
    const int tid = tid_o(), row = tid >> 1, half = tid & 1; const bf16_t* p = A + (size_t)row * LDC + half * (KC / 2); float s = 0.f;
#pragma unroll
    for (int i = 0; i < KC / 16; ++i) { const u32x4 w = *(const u32x4*)(p + i * 8);
        s += bflo(w.x) * bflo(w.x) + bfhi(w.x) * bfhi(w.x) + bflo(w.y) * bflo(w.y) + bfhi(w.y) * bfhi(w.y) + bflo(w.z) * bflo(w.z) + bfhi(w.z) * bfhi(w.z) + bflo(w.w) * bflo(w.w) + bfhi(w.w) * bfhi(w.w); }
    s += dppf<0xB1>(s);
    if (half == 0) rsl[row] = __builtin_amdgcn_rsqf(s * (1.f / KC) + EPS) * sc;
    __syncthreads();
}
struct Args { const float* in[25]; float* out; unsigned char* ws; };
typedef const unsigned char __attribute__((address_space(4))) kconst_t;
__device__ __forceinline__ kconst_t* karg() { kconst_t* p = (kconst_t*)__builtin_amdgcn_kernarg_segment_ptr(); asm volatile("" : "+s"(p)); return p; }
#define IN(i) (((const float* const __attribute__((address_space(4)))*)karg())[i])
#define OUTP (((float* const __attribute__((address_space(4)))*)karg())[25])
#define WSP(type, off) ((type*)((((unsigned char* const __attribute__((address_space(4)))*)karg())[26]) + (off)))
#define WL(L) (WSP(bf16_t, WS_W) + (size_t)(L) * WL_ELEMS)
__device__ __forceinline__ LayerP layer_p(int L) { LayerP P;
    P.ssd_conv_w = IN(7) + (size_t)L * 4 * 768; P.ssd_conv_b = IN(8) + (size_t)L * 768; P.ssd_dt_bias = IN(9) + L * 8; P.ssd_a_log = IN(10) + L * 8;
    P.ssd_d = IN(11) + L * 8; P.ssd_norm_g = IN(12) + (size_t)L * 512; P.gdn_conv_w = IN(17) + (size_t)L * 4 * 768; P.gdn_dt_bias = IN(18) + L * 4;
    P.gdn_a_log = IN(19) + L * 4; P.gdn_norm_g = IN(20) + L * 64; return P; }

template <int PH>
__device__ __forceinline__ void run_phase(LAS unsigned char* lds, const int L, const int f, const int G) {
    constexpr float LOG2E = 1.4426950408889634f;
    if constexpr (PH == 0) {
        for (int l = 0; l < DEPTH; ++l) { bf16_t* wl = WL(l);
            convert_w(lds, IN(4) + ((size_t)l * 2 + 0) * D * 2 * FF, D, 2 * FF, 2 * FF, wl + W_UP0, 1, nullptr);
            convert_w(lds, IN(4) + ((size_t)l * 2 + 1) * D * 2 * FF, D, 2 * FF, 2 * FF, wl + W_UP1, 1, nullptr);
            convert_w(lds, IN(5) + ((size_t)l * 2 + 0) * FF * D, FF, D, D, wl + W_DN0, 0, nullptr);
            convert_w(lds, IN(5) + ((size_t)l * 2 + 1) * FF * D, FF, D, D, wl + W_DN1, 0, nullptr);
            convert_w(lds, IN(6) + (size_t)l * D * 2736, D, 2736, LDC, wl + W_IN, 0, nullptr);
            convert_w(lds, IN(21) + (size_t)l * D * D, D, D, D, wl + W_OUT, 0, nullptr);
            convert_w(lds, IN(22) + (size_t)l * D * D, D, D, D, wl + W_XQ, 0, nullptr);
            convert_w(lds, IN(23) + (size_t)l * D * 2 * D, D, 2 * D, 2 * D, wl + W_XKV, 0, nullptr);
            convert_w(lds, IN(24) + (size_t)l * D * D, D, D, D, wl + W_XO, 0, nullptr);
            convert_w(lds, IN(14) + (size_t)l * 256 * 384, 256, 384, 512, wl + W_UQ, 2, IN(13) + (size_t)l * 256);
            convert_w(lds, IN(16) + (size_t)l * 128 * 512, 128, 512, 512, wl + W_UKV, 0, IN(15) + (size_t)l * 128);
            norm_rows(IN(1), NB * NMEM, IN(3) + ((size_t)l * 9 + 4) * D, WSP(bf16_t, WS_MEMN) + (size_t)l * 2048 * 1024, nullptr);
        }
        norm_rows(IN(0), T, IN(3), WSP(bf16_t, WS_HB), OUTP);
        const int gt = bid_o() * NT + tid_o(), gn = G * NT; const int* positions = (const int*)IN(2);
        float* cosT = WSP(float, WS_COS); float* sinT = WSP(float, WS_SIN);
        for (int i = gt; i < T * 16; i += gn) { const int tok = i >> 4, fi = i & 15;
            const float inv = 1.0f / powf(10000.0f, (float)(2 * fi) / 32.0f); const float ang = (float)positions[tok] * inv;
            double rev = (double)ang * 0.15915494309189535; rev -= rint(rev); const float rv = (float)rev;
            cosT[i] = __builtin_amdgcn_cosf(rv); sinT[i] = __builtin_amdgcn_sinf(rv); }
        if (gt < 1024) WSP(unsigned, WS_CTL)[gt] = 0u;
        if (gt < 4096) WSP(unsigned, WS_XBAR)[gt] = 0u;
    } else if constexpr (PH == 1) {
        const int bx = bid_o(); const int l = bx >> 6; if (l < DEPTH) { pg8::Gemm g{WSP(bf16_t, WS_MEMN) + (size_t)l * 2048 * 1024, WL(l) + W_XKV, D, D, 2048, 2048, D};
            pg8::StaticOrder S; S.init(2048, 2048, 64, bx & 63); pg8::EpiXaKV E{WSP(bf16_t, WS_XK) + (size_t)l * 2048 * 1024, WSP(bf16_t, WS_XVT) + (size_t)l * 1024 * 2048};
            pg8::gemm_phase(lds, g, S, E); }
    } else if constexpr (PH == 2) {
        pg8::Gemm g{WSP(bf16_t, WS_HB), WL(L) + (f ? W_UP1 : W_UP0), D, D, T, 2 * FF, D}; pg8::StaticOrder S; S.init(T, 2 * FF, G, bid_o()); pg8::EpiSwiGLU E{WSP(bf16_t, WS_BIG)}; pg8::gemm_phase(lds, g, S, E);
    } else if constexpr (PH == 3) {
        pg8::Gemm g{WSP(bf16_t, WS_BIG), WL(L) + (f ? W_DN1 : W_DN0), FF, FF, T, D, FF}; pg8::StaticOrder S; S.init(T, D, G, bid_o()); pg8::EpiBf16S E{WSP(bf16_t, WS_TBUF), D, 1.0f}; pg8::gemm_phase(lds, g, S, E);
    } else if constexpr (PH == 4) {
        const float* ng = IN(3) + (size_t)L * 9 * D;
        if (f == 0) post_rows(WSP(bf16_t, WS_TBUF), OUTP, 0.5f, ng + 1 * D, ng + 2 * D, WSP(bf16_t, WS_HB));
        else post_rows(WSP(bf16_t, WS_TBUF), OUTP, 0.5f, ng + 8 * D, (L + 1 < DEPTH) ? ng + 9 * D : nullptr, WSP(bf16_t, WS_HB));
    } else if constexpr (PH == 5) {
        pg8::Gemm g{WSP(bf16_t, WS_HB), WL(L) + W_IN, D, D, T, LDC, D}; pg8::StaticOrder S; S.init(T, LDC, G, bid_o()); pg8::EpiBf16S E{WSP(bf16_t, WS_BIG), LDC, 1.0f}; pg8::gemm_phase(lds, g, S, E);
    } else if constexpr (PH == 6) {
        { int kq = 256; asm volatile("" : "+s"(kq));
            pg8::Gemm g{WSP(bf16_t, WS_BIG) + MLA_CQ, WL(L) + W_UQ, LDC, 256, T, 512, kq}; pg8::StaticOrder S; S.init(T, 512, G, bid_o());
            pg8::Unit u0; LAS float* rsl = (LAS float*)(lds + 131072);
            if (S.next(0, u0)) row_scales<256>(g.A + (size_t)u0.pm * 256 * LDC, rsl, 0.10206207261596577f * LOG2E);
            pg8::EpiMlaQ E{WSP(bf16_t, WS_MQ), rsl}; pg8::gemm_phase(lds, g, S, E); }
    } else if constexpr (PH == 15) {
        { int kq = 128; asm volatile("" : "+s"(kq));
            pg8::Gemm g{WSP(bf16_t, WS_BIG) + MLA_CKV, WL(L) + W_UKV, LDC, 128, T, 512, kq}; pg8::StaticOrder S; S.init(T, 512, G, bid_o());
            pg8::Unit u0; LAS float* rsl = (LAS float*)(lds + 131072);
            if (S.next(0, u0)) row_scales<128>(g.A + (size_t)u0.pm * 256 * LDC, rsl, 1.0f);
            pg8::EpiMlaKV E{WSP(bf16_t, WS_MK), WSP(bf16_t, WS_MVT), rsl}; pg8::gemm_phase(lds, g, S, E); }
    } else if constexpr (PH == 16) {
        { const int gt = bid_o() * NT + tid_o(), gn = G * NT; const bf16_t* big = WSP(bf16_t, WS_BIG); const float* cosT = WSP(float, WS_COS); const float* sinT = WSP(float, WS_SIN); bf16_t* mk = WSP(bf16_t, WS_MK);
            for (int i = gt; i < T * 16; i += gn) { const int tok = i >> 4, f2 = i & 15;
                const float x1 = bf2f(big[(size_t)tok * LDC + MLA_KR + f2]), x2 = bf2f(big[(size_t)tok * LDC + MLA_KR + 16 + f2]);
                const float c = cosT[i], s = sinT[i]; const bf16_t o1 = (bf16_t)f2bf(x1 * c - x2 * s), o2 = (bf16_t)f2bf(x2 * c + x1 * s);
                const int p1 = 8 * (f2 >> 2) + (f2 & 3); bf16_t* kp = mk + (size_t)tok * 384 + 64 + p1;
#pragma unroll
                for (int hh = 0; hh < 4; ++hh) { kp[hh * 96] = o1; kp[hh * 96 + 4] = o2; } } }
        { const LayerP P = layer_p(L); const bf16_t* big = WSP(bf16_t, WS_BIG); bf16_t* gp = WSP(bf16_t, WS_GP); float* gdec = WSP(float, WS_GDEC);
            for (int it = bid_o(); it < 2048; it += G) gdn_prep_item(lds, big, P, gp, gdec, it);
            for (int it = bid_o(); it < 256; it += G) ssd_prep_range(lds, big, P, WSP(bf16_t, WS_Y), WSP(bf16_t, WS_SST), WSP(float, WS_SAC), WSP(bf16_t, WS_CMS), it >> 5, (it >> 2) & 7, (it & 3) * 16, (it & 3) * 16 + 16); }
    } else if constexpr (PH == 7) {
        volatile LAS int* sh_item = (volatile LAS int*)(lds + MISC_OFF);
        unsigned* done = WSP(unsigned, WS_CTL) + 128 + L * 2 + f;
        for (;;) {
            __syncthreads();
            if (tid_o() == 0) *sh_item = (int)atomicAdd(WSP(unsigned, WS_CTL) + L + 8 * f, 1u);
            __syncthreads();
            const int item = *sh_item;
            if (item >= 32 + 64 + 1024 + 1024) break;
            if (item < 32) { const LayerP P = layer_p(L); gdn_scan_item(lds, WSP(bf16_t, WS_BIG), P, WSP(bf16_t, WS_GP), WSP(float, WS_GDEC), WSP(bf16_t, WS_Y), item); }
            else if (item < 96) { ssd_state_scan_item(lds, WSP(bf16_t, WS_SST), WSP(float, WS_SAC), item - 32);
                __syncthreads();
                if (tid_o() == 0) { __builtin_amdgcn_fence(__ATOMIC_RELEASE, "agent"); __hip_atomic_fetch_add(done, 1u, __ATOMIC_RELAXED, __HIP_MEMORY_SCOPE_AGENT); } }
            else if (item < 96 + 1024) { const int a = item - 96, qb = 31 - (a >> 5), b = (a & 31) >> 2, hh = a & 3; const size_t row0 = (size_t)b * SEQ + qb * 128;
                attn_item<96, 64, 2>(lds, WSP(bf16_t, WS_MQ) + row0 * 512 + hh * 96, 512, WSP(bf16_t, WS_MK) + (size_t)b * SEQ * 384 + hh * 96, 384, WSP(bf16_t, WS_MVT) + (size_t)(b * 256 + hh * 64) * 4096, 4096,
                                     WSP(bf16_t, WS_Y) + row0 * 1024 + 512 + hh * 64, 1024, 2 * qb + 2, 2 * qb + 1, WSP(float, WS_COS) + row0 * 16, WSP(float, WS_SIN) + row0 * 16); }
            else {
                if (tid_o() == 0) { while (__hip_atomic_load(done, __ATOMIC_RELAXED, __HIP_MEMORY_SCOPE_AGENT) < 64u) __builtin_amdgcn_s_sleep(2);
                    __builtin_amdgcn_fence(__ATOMIC_ACQUIRE, "agent"); }
                __syncthreads();
                ssd_finish_item(lds, WSP(bf16_t, WS_BIG), IN(12) + (size_t)L * 512, WSP(bf16_t, WS_Y), WSP(bf16_t, WS_SST), WSP(float, WS_SAC), WSP(bf16_t, WS_CMS), item - (96 + 1024)); }
        }
    } else if constexpr (PH == 8) {
        { const float* ngs = IN(12) + (size_t)L * 512; for (int it = bid_o(); it < 1024; it += G) ssd_finish_item(lds, WSP(bf16_t, WS_BIG), ngs, WSP(bf16_t, WS_Y), WSP(bf16_t, WS_SST), WSP(float, WS_SAC), WSP(bf16_t, WS_CMS), it); }
    } else if constexpr (PH == 9) {
        pg8::Gemm g{WSP(bf16_t, WS_Y), WL(L) + W_OUT, D, D, T, D, D}; pg8::StaticOrder S; S.init(T, D, G, bid_o()); pg8::EpiBf16S E{WSP(bf16_t, WS_TBUF), D, 1.0f}; pg8::gemm_phase(lds, g, S, E);
    } else if constexpr (PH == 10) {
        const float* ng = IN(3) + (size_t)L * 9 * D; post_rows(WSP(bf16_t, WS_TBUF), OUTP, 1.0f, ng + 3 * D, ng + 5 * D, WSP(bf16_t, WS_HB));
    } else if constexpr (PH == 11) {
        pg8::Gemm g{WSP(bf16_t, WS_HB), WL(L) + W_XQ, D, D, T, D, D}; pg8::StaticOrder S; S.init(T, D, G, bid_o()); pg8::EpiBf16S E{WSP(bf16_t, WS_BIG), D, 0.0625f * LOG2E}; pg8::gemm_phase(lds, g, S, E);
    } else if constexpr (PH == 12) {
        for (int it = bid_o(); it < 1024; it += G) { const int qb = it >> 5, b = (it & 31) >> 2, hh = it & 3; const size_t row0 = (size_t)b * SEQ + qb * 128;
            attn_item<256, 256, 2>(lds, WSP(bf16_t, WS_BIG) + row0 * 1024 + hh * 256, 1024, WSP(bf16_t, WS_XK) + (size_t)L * 2048 * 1024 + (size_t)b * 256 * 1024 + hh * 256, 1024,
                                WSP(bf16_t, WS_XVT) + (size_t)L * 1024 * 2048 + (size_t)(hh * 256) * 2048 + b * 256, 2048, WSP(bf16_t, WS_Y) + row0 * 1024 + hh * 256, 1024, 4, 4, nullptr, nullptr); }
    } else if constexpr (PH == 13) {
        pg8::Gemm g{WSP(bf16_t, WS_Y), WL(L) + W_XO, D, D, T, D, D}; pg8::StaticOrder S; S.init(T, D, G, bid_o()); pg8::EpiBf16S E{WSP(bf16_t, WS_TBUF), D, 1.0f}; pg8::gemm_phase(lds, g, S, E);
    } else if constexpr (PH == 14) {
        const float* ng = IN(3) + (size_t)L * 9 * D; post_rows(WSP(bf16_t, WS_TBUF), OUTP, 1.0f, ng + 6 * D, ng + 7 * D, WSP(bf16_t, WS_HB));
    }
}

#ifndef MONO
#define MONO 1
#endif
#define XB_TMO      128
#define XB_XCNT(j)  (256  + 64 * (j))
#define XB_XSUB(j)  (1280 + 64 * (j))
#define XB_XGEN(j)  (2304 + 64 * (j))
#define XB_TOP      3328
#define XB_TOPGEN   3392
#define XCD_BAR_WORDS 3456
#define XB_SPIN_CAP (1u << 18)
__device__ __forceinline__ unsigned xb_ld(unsigned* p)              { return __hip_atomic_load(p, __ATOMIC_RELAXED, __HIP_MEMORY_SCOPE_AGENT); }
__device__ __forceinline__ unsigned xb_add(unsigned* p, unsigned v) { return __hip_atomic_fetch_add(p, v, __ATOMIC_RELAXED, __HIP_MEMORY_SCOPE_AGENT); }
__device__ __forceinline__ unsigned xb_xcc_id() { return (unsigned)__builtin_amdgcn_s_getreg((3 << 11) | 20) & 0xFu; }
#define XB_SPIN(cond, bar) do { unsigned _sp = 0; while (cond) { __builtin_amdgcn_s_sleep(1); \
    if ((++_sp & 255u) == 0u) { if (xb_ld(&(bar)[XB_TMO])) break; if (_sp > XB_SPIN_CAP) { atomicAdd(&(bar)[XB_TMO], 1u); break; } } } } while (0)
__device__ __forceinline__ void xcd_barrier_complete(unsigned* bar, unsigned x, unsigned& nloc, unsigned& nx) {
    const unsigned G = gridDim.x;
    unsigned sum, cnt, mine, sp = 0u;
    for (;;) {
        sum = 0u; cnt = 0u; mine = 0u;
#pragma unroll
        for (unsigned j = 0; j < 16; ++j) { const unsigned c = xb_ld(&bar[XB_XCNT(j)]); sum += c; cnt += (c > 0u) ? 1u : 0u; mine = (j == x) ? c : mine; }
        if (sum == G) break;
        __builtin_amdgcn_s_sleep(1);
        if ((++sp & 255u) == 0u) { if (xb_ld(&bar[XB_TMO])) break; if (sp > XB_SPIN_CAP) { atomicAdd(&bar[XB_TMO], 1u); break; } }
    }
    nloc = mine > 0u ? mine : 1u; nx = cnt > 0u ? cnt : 1u;
}
__device__ __forceinline__ void xcd_barrier(unsigned* bar, volatile LAS unsigned* st) {
    asm volatile("s_waitcnt vmcnt(0)" ::: "memory");
    __syncthreads();
    if (tid_o() == 0) {
        const unsigned x = xb_xcc_id();
        __builtin_amdgcn_s_waitcnt(0);
        unsigned nloc = st[0], nx = st[1];
        if (nloc == 0u) { xcd_barrier_complete(bar, x, nloc, nx); st[0] = nloc; st[1] = nx; }
        const unsigned old = xb_add(&bar[XB_XSUB(x)], 1u);
        const unsigned gen = old / nloc;
        if (old + 1u == (gen + 1u) * nloc) {
            __builtin_amdgcn_fence(__ATOMIC_RELEASE, "agent");
            asm volatile("s_waitcnt vmcnt(0)" ::: "memory");
            const unsigned og = xb_add(&bar[XB_TOP], 1u);
            const unsigned tg = og / nx;
            if (og + 1u == (tg + 1u) * nx) xb_add(&bar[XB_TOPGEN], 1u);
            else XB_SPIN(xb_ld(&bar[XB_TOPGEN]) == tg, bar);
            __builtin_amdgcn_fence(__ATOMIC_ACQUIRE, "agent");
            xb_add(&bar[XB_XGEN(x)], 1u);
            asm volatile("s_waitcnt vmcnt(0)" ::: "memory");
        } else {
            XB_SPIN(xb_ld(&bar[XB_XGEN(x)]) == gen, bar);
            __builtin_amdgcn_fence(__ATOMIC_ACQUIRE, "agent");
            asm volatile("s_waitcnt vmcnt(0)" ::: "memory");
        }
    }
    __syncthreads();
}

#if MONO
#ifndef REP_MASK
#define REP_MASK 0u
#endif
#ifndef CG_SYNC
#define CG_SYNC 0
#endif
__device__ __forceinline__ void gsync(unsigned* ctr, unsigned target) {
    __syncthreads();
    if (tid_o() == 0) {
        __builtin_amdgcn_fence(__ATOMIC_RELEASE, "agent");
        __hip_atomic_fetch_add(ctr, 1u, __ATOMIC_RELAXED, __HIP_MEMORY_SCOPE_AGENT);
        while (__hip_atomic_load(ctr, __ATOMIC_RELAXED, __HIP_MEMORY_SCOPE_AGENT) < target) __builtin_amdgcn_s_sleep(1);
        __builtin_amdgcn_fence(__ATOMIC_ACQUIRE, "agent");
    }
    __syncthreads();
}
__global__ void __launch_bounds__(NT, 2) fwd_kernel(Args args) {
    extern __shared__ __attribute__((aligned(16))) unsigned char lds_raw[];
    LAS unsigned char* lds = (LAS unsigned char*)lds_raw;
    cg::grid_group grid = cg::this_grid();
    const int G = gridDim.x;
    unsigned nb = 0;
    if ((threadIdx.x & 63) == 0) *(volatile LAS int*)(unsigned)(MISC_OFF + 64 + hw_slot() * 4) = (int)(threadIdx.x >> 6);
    if (threadIdx.x < 2) *(volatile LAS unsigned*)(unsigned)(MISC_OFF + 8 + threadIdx.x * 4) = 0u;
    __syncthreads();
#if CG_SYNC
#define GSYNC() grid.sync()
#else
#define GSYNC() xcd_barrier(WSP(unsigned, WS_XBAR), (volatile LAS unsigned*)(lds + MISC_OFF + 8))
#endif
#define RUN(P, L, f) do { run_phase<P>(lds, L, f, G); if ((REP_MASK >> P) & 1u) { GSYNC(); run_phase<P>(lds, L, (P == 7) ? 1 : f, G); } } while (0)
    run_phase<0>(lds, 0, 0, G); grid.sync();
    if (tid_o() == 0) (void)xb_add(WSP(unsigned, WS_XBAR) + XB_XCNT(xb_xcc_id()), 1u);
    run_phase<1>(lds, 0, 0, G); GSYNC();
#define LAYER(L) \
        RUN(2, L, 0); GSYNC(); RUN(3, L, 0); GSYNC(); run_phase<4>(lds, L, 0, G); GSYNC(); \
        RUN(5, L, 0); GSYNC(); RUN(6, L, 0); __syncthreads(); RUN(15, L, 0); __syncthreads(); RUN(16, L, 0); GSYNC(); RUN(7, L, 0); GSYNC(); \
        RUN(9, L, 0); GSYNC(); run_phase<10>(lds, L, 0, G); GSYNC(); \
        RUN(11, L, 0); GSYNC(); RUN(12, L, 0); GSYNC(); RUN(13, L, 0); GSYNC(); run_phase<14>(lds, L, 0, G); GSYNC(); \
        RUN(2, L, 1); GSYNC(); RUN(3, L, 1); GSYNC(); run_phase<4>(lds, L, 1, G); GSYNC();
    LAYER(0) LAYER(1) LAYER(2) LAYER(3)
#undef LAYER
#undef RUN
#undef GSYNC
}
#else
template <int PH>
__global__ void __launch_bounds__(NT, 2) phase_kernel(Args args, int L, int f) {
    extern __shared__ __attribute__((aligned(16))) unsigned char lds_raw[];
    if ((threadIdx.x & 63) == 0) *(volatile LAS int*)(unsigned)(MISC_OFF + 64 + hw_slot() * 4) = (int)(threadIdx.x >> 6);
    __syncthreads();
    run_phase<PH>((LAS unsigned char*)lds_raw, L, f, gridDim.x);
}
#endif

#if !MONO
#ifndef PH_MASK
#define PH_MASK 0x1FFFFu
#endif
template <int PH> static void launch_phase(const Args& a, int L, int f, int grid, hipStream_t stream) {
    if (!((PH_MASK >> PH) & 1u)) return;
    static bool attr = false;
    if (!attr) { (void)hipFuncSetAttribute((const void*)phase_kernel<PH>, hipFuncAttributeMaxDynamicSharedMemorySize, LDS_BYTES); attr = true; }
    hipLaunchKernelGGL(phase_kernel<PH>, dim3(grid), dim3(NT), LDS_BYTES, stream, a, L, f);
}
#endif
extern "C" void kernel_launch(void* const* d_in, const int* in_sizes, int n_in, void* d_out, int out_size, void* d_ws, size_t ws_size, hipStream_t stream) {
    static int grid = 0;
    if (grid == 0) {
        if (n_in != 25 || out_size != T * D || ws_size < WS_END) { fprintf(stderr, "kernel_launch: unexpected shapes (n_in %d out %d ws %zu need %zu)\n", n_in, out_size, ws_size, (size_t)WS_END); grid = -1; return; }
        int dev = 0, cus = 0;
        (void)hipGetDevice(&dev); (void)hipDeviceGetAttribute(&cus, hipDeviceAttributeMultiprocessorCount, dev);
#if MONO
        int per_cu = 0;
        if (hipFuncSetAttribute((const void*)fwd_kernel, hipFuncAttributeMaxDynamicSharedMemorySize, LDS_BYTES) != hipSuccess) { fprintf(stderr, "kernel_launch: hipFuncSetAttribute failed\n"); grid = -1; return; }
        if (hipOccupancyMaxActiveBlocksPerMultiprocessor(&per_cu, (const void*)fwd_kernel, NT, LDS_BYTES) != hipSuccess || per_cu < 1) fprintf(stderr, "kernel_launch: occupancy query gave %d\n", per_cu);
        (void)hipGetLastError();
#endif
        grid = cus;
        if (cus != 256) { fprintf(stderr, "kernel_launch: built for 256 CUs, got %d\n", cus); grid = -1; return; }
    }
    if (grid < 0) return;
    Args a{};
    for (int i = 0; i < 25; ++i) a.in[i] = (const float*)d_in[i];
    a.out = (float*)d_out; a.ws = (unsigned char*)d_ws;
#if MONO
    void* kargs[] = {&a};
    hipError_t e = hipLaunchCooperativeKernel((const void*)fwd_kernel, dim3(grid), dim3(NT), kargs, LDS_BYTES, stream);
    if (e != hipSuccess) fprintf(stderr, "cooperative launch failed: %s (grid %d)\n", hipGetErrorString(e), grid);
#else
    launch_phase<0>(a, 0, 0, grid, stream); launch_phase<1>(a, 0, 0, grid, stream);
    for (int L = 0; L < DEPTH; ++L) {
        launch_phase<2>(a, L, 0, grid, stream); launch_phase<3>(a, L, 0, grid, stream); launch_phase<4>(a, L, 0, grid, stream);
        launch_phase<5>(a, L, 0, grid, stream); launch_phase<6>(a, L, 0, grid, stream); launch_phase<15>(a, L, 0, grid, stream); launch_phase<16>(a, L, 0, grid, stream); launch_phase<7>(a, L, 0, grid, stream);
        launch_phase<9>(a, L, 0, grid, stream); launch_phase<10>(a, L, 0, grid, stream);
        launch_phase<11>(a, L, 0, grid, stream); launch_phase<12>(a, L, 0, grid, stream); launch_phase<13>(a, L, 0, grid, stream); launch_phase<14>(a, L, 0, grid, stream);
        launch_phase<2>(a, L, 1, grid, stream); launch_phase<3>(a, L, 1, grid, stream); launch_phase<4>(a, L, 1, grid, stream);
    }
#endif
}
```
